# Optimizing an MI355X kernel written in HIP

```python
import math
import jax, jax.numpy as jnp
from jax import lax
import numpy as np

D_MODEL = 1024
BATCH = 16
SEQ = 2048
DEPTH = 1
DEC_BATCH = 4
DEC_SEQ = 4096
PAST_LEN = 128

HEAD_DIM = 64
N_HEADS_A = 8
N_KV_A = 2
N_HEADS_B = 8
N_KV_B = 2
G_A = N_HEADS_A // N_KV_A
G_B = N_HEADS_B // N_KV_B
WIDTH_A = N_HEADS_A * HEAD_DIM
WIDTH_B = N_HEADS_B * HEAD_DIM
KVW_A = N_KV_A * HEAD_DIM
KVW_B = N_KV_B * HEAD_DIM
IN_WIDTH = WIDTH_A + 2 * KVW_A + WIDTH_B + 2 * KVW_B
BLOCK = 128
WINDOW = 128
GRID_W = 64
ROPE_THETA = 10000.0
ROPE_HALF = HEAD_DIM // 2
N_BUCKETS = 32
MAX_DISTANCE = 128
D_FF = int(math.ceil((8 * D_MODEL / 3) / 256) * 256)
EPS = 1e-6
NEG_INF = -1e30

kernel_name = "hybrid_gqa_window_sink_encoder"


def rmsnorm(x, gain):
    xf = x.astype(jnp.float32)
    var = jnp.mean(xf * xf, axis=-1, keepdims=True)
    return (xf * lax.rsqrt(var + EPS) * gain.astype(jnp.float32)).astype(x.dtype)


def rotate_half(x):
    x1, x2 = jnp.split(x, 2, axis=-1)
    return jnp.concatenate([-x2, x1], axis=-1)


def axial_rope_tables(S):
    ROWS = S // GRID_W
    pos = jnp.arange(S)
    rows = jnp.repeat(jnp.arange(ROWS), GRID_W).astype(jnp.float32)
    cols = (pos % GRID_W).astype(jnp.float32)
    inv_freq = 1.0 / (ROPE_THETA ** (jnp.arange(0, ROPE_HALF, 2, dtype=jnp.float32) / ROPE_HALF))
    fr = rows[:, None] * inv_freq[None, :]
    fc = cols[:, None] * inv_freq[None, :]
    er = jnp.concatenate([fr, fr], axis=-1)
    ec = jnp.concatenate([fc, fc], axis=-1)
    return jnp.cos(er), jnp.sin(er), jnp.cos(ec), jnp.sin(ec)


def apply_axial_rope(x, tables):
    cr, sr, cc, sc = tables
    xr, xc = x[..., :ROPE_HALF], x[..., ROPE_HALF:]
    dt = x.dtype
    cr, sr, cc, sc = (t[None, :, None, :].astype(dt) for t in (cr, sr, cc, sc))
    yr = xr * cr + rotate_half(xr) * sr
    yc = xc * cc + rotate_half(xc) * sc
    return jnp.concatenate([yr, yc], axis=-1)


def t5_bucket(rel):
    half = N_BUCKETS // 2
    max_exact = half // 2
    ret = jnp.where(rel > 0, half, 0)
    n = jnp.abs(rel)
    nf = jnp.maximum(n, 1).astype(jnp.float32)
    large = max_exact + (jnp.log(nf / max_exact) / math.log(MAX_DISTANCE / max_exact) * (half - max_exact)).astype(jnp.int32)
    large = jnp.minimum(large, half - 1)
    return ret + jnp.where(n < max_exact, n, large)


def global_attention(q, k, v):
    B, S, KV, G, D = q.shape
    nb = S // BLOCK
    scale = 1.0 / math.sqrt(D)
    qb = q.reshape(B, nb, BLOCK, KV, G, D).transpose(1, 0, 2, 3, 4, 5)
    kf = k.astype(jnp.float32)
    vf = v.astype(jnp.float32)

    def one_block(qblk):
        s = jnp.einsum('bqkgd,bskd->bkgqs', qblk.astype(jnp.float32), kf) * scale
        p = jax.nn.softmax(s, axis=-1)
        o = jnp.einsum('bkgqs,bskd->bqkgd', p, vf)
        return o.astype(q.dtype)

    out = lax.map(one_block, qb)
    return out.transpose(1, 0, 2, 3, 4, 5).reshape(B, S, KV * G * D)


def window_attention(q, k, v, sink, rel_bias):
    B, S, KV, G, D = q.shape
    nb = S // BLOCK
    scale = 1.0 / math.sqrt(D)
    qb = q.reshape(B, nb, BLOCK, KV, G, D)
    pad = ((0, 0), (BLOCK, BLOCK), (0, 0), (0, 0))
    kp = jnp.pad(k, pad).reshape(B, nb + 2, BLOCK, KV, D)
    vp = jnp.pad(v, pad).reshape(B, nb + 2, BLOCK, KV, D)
    kw = jnp.concatenate([kp[:, :-2], kp[:, 1:-1], kp[:, 2:]], axis=2)
    vw = jnp.concatenate([vp[:, :-2], vp[:, 1:-1], vp[:, 2:]], axis=2)
    s = jnp.einsum('bnqkgd,bnckd->bnkgqc', qb.astype(jnp.float32), kw.astype(jnp.float32)) * scale
    a = jnp.arange(BLOCK)[:, None]
    c = jnp.arange(3 * BLOCK)[None, :]
    rel = c - BLOCK - a
    qpos = jnp.arange(nb)[:, None, None] * BLOCK + a[None]
    kpos = qpos + rel[None]
    valid = (jnp.abs(rel)[None] <= WINDOW) & (kpos >= 0) & (kpos < S)
    bias = rel_bias.astype(jnp.float32)[t5_bucket(rel)]
    bias = bias.transpose(2, 0, 1).reshape(KV, G, BLOCK, 3 * BLOCK)
    s = s + bias[None, None]
    s = jnp.where(valid[None, :, None, None], s, NEG_INF)
    sk = sink.astype(jnp.float32).reshape(1, 1, KV, G, 1, 1)
    m = jnp.maximum(jnp.max(s, axis=-1, keepdims=True), sk)
    p = jnp.exp(s - m)
    denom = jnp.sum(p, axis=-1, keepdims=True) + jnp.exp(sk - m)
    o = jnp.einsum('bnkgqc,bnckd->bnqkgd', p / denom, vw.astype(jnp.float32))
    return o.astype(q.dtype).reshape(B, S, KV * G * D)


def encoder_layer(x, norm_mix_pre, norm_mix_post, w_in, q_norm_a, k_norm_a, sink_b, rel_bias,
                  w_branch_a, w_branch_b, w_gate, b_gate, w_out,
                  norm_ffn_pre, norm_ffn_post, w_ffn_gate, w_ffn_up, w_ffn_down):
    B, S, _ = x.shape
    h = rmsnorm(x, norm_mix_pre)
    proj = h @ w_in
    o1 = WIDTH_A
    o2 = o1 + KVW_A
    o3 = o2 + KVW_A
    o4 = o3 + WIDTH_B
    o5 = o4 + KVW_B
    qa = proj[..., :o1].reshape(B, S, N_HEADS_A, HEAD_DIM)
    ka = proj[..., o1:o2].reshape(B, S, N_KV_A, HEAD_DIM)
    va = proj[..., o2:o3].reshape(B, S, N_KV_A, HEAD_DIM)
    qb = proj[..., o3:o4].reshape(B, S, N_KV_B, G_B, HEAD_DIM)
    kb = proj[..., o4:o5].reshape(B, S, N_KV_B, HEAD_DIM)
    vb = proj[..., o5:].reshape(B, S, N_KV_B, HEAD_DIM)

    tables = axial_rope_tables(S)
    qa = apply_axial_rope(rmsnorm(qa, q_norm_a), tables).reshape(B, S, N_KV_A, G_A, HEAD_DIM)
    ka = apply_axial_rope(rmsnorm(ka, k_norm_a), tables)
    ya = global_attention(qa, ka, va)

    yb = window_attention(qb, kb, vb, sink_b, rel_bias)

    gates = jax.nn.sigmoid((h @ w_gate + b_gate).astype(jnp.float32)).astype(x.dtype)
    mix = gates[..., :D_MODEL] * (ya @ w_branch_a) + gates[..., D_MODEL:] * (yb @ w_branch_b)
    x = x + rmsnorm(mix @ w_out, norm_mix_post)

    h2 = rmsnorm(x, norm_ffn_pre)
    f = (jax.nn.silu(h2 @ w_ffn_gate) * (h2 @ w_ffn_up)) @ w_ffn_down
    return x + rmsnorm(f, norm_ffn_post)


def setup_inputs(seed: int = 0) -> dict:
    key = jax.random.key(seed)
    ks = jax.random.split(key, 24)
    f32 = jnp.float32

    def w(k, shape, fan_in):
        return jax.random.normal(k, shape, f32) * (fan_in ** -0.5)

    def gain(k, shape):
        return 1.0 + 0.05 * jax.random.normal(k, shape, f32)

    return {
        "x_prompt": jax.random.normal(ks[0], (BATCH, SEQ, D_MODEL), f32),
        "x_sample": jax.random.normal(ks[1], (DEC_BATCH, DEC_SEQ, D_MODEL), f32),
        "norm_mix_pre": gain(ks[2], (DEPTH, D_MODEL)),
        "norm_mix_post": gain(ks[3], (DEPTH, D_MODEL)),
        "w_in": w(ks[4], (DEPTH, D_MODEL, IN_WIDTH), D_MODEL),
        "q_norm_a": gain(ks[5], (DEPTH, HEAD_DIM)),
        "k_norm_a": gain(ks[6], (DEPTH, HEAD_DIM)),
        "sink_b": 0.5 * jax.random.normal(ks[7], (DEPTH, N_HEADS_B), f32),
        "rel_bias": 0.1 * jax.random.normal(ks[8], (N_BUCKETS, N_HEADS_B), f32),
        "w_branch_a": w(ks[9], (DEPTH, WIDTH_A, D_MODEL), WIDTH_A),
        "w_branch_b": w(ks[10], (DEPTH, WIDTH_B, D_MODEL), WIDTH_B),
        "w_gate": w(ks[11], (DEPTH, D_MODEL, 2 * D_MODEL), D_MODEL),
        "b_gate": 0.02 * jax.random.normal(ks[12], (DEPTH, 2 * D_MODEL), f32),
        "w_out": w(ks[13], (DEPTH, D_MODEL, D_MODEL), D_MODEL),
        "norm_ffn_pre": gain(ks[14], (DEPTH, D_MODEL)),
        "norm_ffn_post": gain(ks[15], (DEPTH, D_MODEL)),
        "w_ffn_gate": w(ks[16], (DEPTH, D_MODEL, D_FF), D_MODEL),
        "w_ffn_up": w(ks[17], (DEPTH, D_MODEL, D_FF), D_MODEL),
        "w_ffn_down": w(ks[18], (DEPTH, D_FF, D_MODEL), D_FF),
    }


def reference(x_prompt, x_sample, norm_mix_pre, norm_mix_post, w_in, q_norm_a, k_norm_a, sink_b,
              rel_bias, w_branch_a, w_branch_b, w_gate, b_gate, w_out,
              norm_ffn_pre, norm_ffn_post, w_ffn_gate, w_ffn_up, w_ffn_down):
    y_prompt = x_prompt
    y_sample = x_sample
    for l in range(DEPTH):
        layer_args = (norm_mix_pre[l], norm_mix_post[l], w_in[l], q_norm_a[l], k_norm_a[l], sink_b[l],
                      rel_bias, w_branch_a[l], w_branch_b[l], w_gate[l], b_gate[l], w_out[l],
                      norm_ffn_pre[l], norm_ffn_post[l], w_ffn_gate[l], w_ffn_up[l], w_ffn_down[l])
        y_prompt = encoder_layer(y_prompt, *layer_args)
        y_sample = encoder_layer(y_sample, *layer_args)
    return (y_prompt, y_sample)
```

```cpp
#include <hip/hip_runtime.h>
#include <cstdio>
#include <cstdint>

#define DBG_PLAIN 0
#ifndef MK_ONE_LAUNCH
#define MK_ONE_LAUNCH 1
#endif

constexpr int DM = 1024, MP = 16 * 2048, MS = 4 * 4096, M = MP + MS;
constexpr int NPROJ = 1536, NGATE = 2048, NCAT1 = NPROJ + NGATE;
constexpr int DFF = 2816, NGU = 2 * DFF;
constexpr float EPS = 1e-6f;
constexpr float LOG2E = 1.4426950408889634f;
constexpr float C2 = 0.125f * LOG2E;

constexpr size_t MiB = 1u << 20;
constexpr size_t WS_CTL = 0, CTL_ZERO_BYTES = 1 * MiB;
constexpr size_t WS_TAB = 1 * MiB;
constexpr size_t TAB_COS = 0, TAB_SIN = 4096, TAB_BT = 8192, TAB_SINK = 8192 + 8 * 260 * 4;
constexpr size_t WS_SS1 = 2 * MiB, WS_SS2 = 5 * MiB;
constexpr size_t WS_WCAT1 = 8 * MiB, WS_WA = 15 * MiB, WS_WB = 16 * MiB, WS_WOUT = 17 * MiB, WS_WGU = 19 * MiB, WS_WDN = 30 * MiB;
constexpr size_t WS_R1 = 36 * MiB;
constexpr size_t WS_PROJ = 132 * MiB;
constexpr size_t WS_GATES = 276 * MiB;
constexpr size_t WS_H2 = 372 * MiB;
constexpr size_t WS_ACT = 36 * MiB;
constexpr size_t WS_F = 300 * MiB;
constexpr size_t WS_END = 468 * MiB;

constexpr int RING_BYTES = 131072;
constexpr int LDSCTL_OFF = RING_BYTES, MISC_OFF = LDSCTL_OFF + 320;
constexpr int LDS_BYTES = 147456;
constexpr int NWAVES = 8;

#define GAS __attribute__((address_space(1)))
#define LAS __attribute__((address_space(3)))
typedef unsigned short bf16_t;
typedef short bf16x8 __attribute__((ext_vector_type(8)));
typedef float f32x4 __attribute__((ext_vector_type(4)));
typedef float f32x2 __attribute__((ext_vector_type(2)));
typedef unsigned u32x4 __attribute__((ext_vector_type(4)));
typedef unsigned u32x2 __attribute__((ext_vector_type(2)));
typedef GAS unsigned gu32;
#define RLX_AGENT __ATOMIC_RELAXED, __HIP_MEMORY_SCOPE_AGENT
#define LDS_WAIT() asm volatile("s_waitcnt lgkmcnt(0)" ::: "memory")
#define VM_WAIT() asm volatile("s_waitcnt vmcnt(0)" ::: "memory")

__device__ __forceinline__ unsigned f2bf(float f) { unsigned u = __builtin_bit_cast(unsigned, f); return (u + 0x7fffu + ((u >> 16) & 1u)) >> 16; }
__device__ __forceinline__ unsigned pk2(float lo, float hi) { return f2bf(lo) | (f2bf(hi) << 16); }
__device__ __forceinline__ float bf_lo(unsigned w) { return __builtin_bit_cast(float, w << 16); }
__device__ __forceinline__ float bf_hi(unsigned w) { return __builtin_bit_cast(float, w & 0xffff0000u); }
typedef __bf16 bf16x2_t __attribute__((ext_vector_type(2)));
__device__ __forceinline__ unsigned cvt_pk_bf16(float lo, float hi) { f32x2 v = {lo, hi}; bf16x2_t b = __builtin_convertvector(v, bf16x2_t); return __builtin_bit_cast(unsigned, b); }
__device__ __forceinline__ float wave_sum(float v) {
#pragma unroll
    for (int o = 1; o < 64; o <<= 1) v += __shfl_xor(v, o);
    return v;
}
__device__ __forceinline__ int seq_mask(int m) { return m < MP ? 2047 : 4095; }

namespace pg8 {
constexpr int BM = 256, BK = 64, HALF = 128, HTB = HALF * BK * 2, STAGE_BYTES = 8 * HTB, NXCD = 8, WGM = 8;
__host__ __device__ __forceinline__ int lds_byte(int r, int c) { const int st = (r >> 4) * 2 + (c >> 5), rr = r & 15, cc = c & 31, ob = rr * 64 + cc * 2; return st * 1024 + (ob ^ (((ob >> 9) & 1) << 5)); }
__host__ __device__ __forceinline__ void stage_rc(int b, int& R, int& C) { const int st = b / 1024, sb = b % 1024, swz = sb ^ (((sb >> 9) & 1) << 5); R = (st >> 1) * 16 + swz / 64; C = (st & 1) * 32 + (swz % 64) / 2; }

struct Unit { int pm, pn, br; };
struct Gemm { const bf16_t* A; const bf16_t* Bt; int lda, ldb, K; size_t a_br, b_br; };

struct StaticOrder {
    int nM, nN, nwg, G, c, pairs;
    __device__ void init(int M_, int N_, int G_, int c_, int pairs_) { nM = M_ / BM; nN = N_ / BM; nwg = nM * nN; G = G_; c = c_; pairs = pairs_; }
    __device__ bool next(int i, Unit& u) const {
        const int ti = pairs ? (i >> 1) : i; u.br = pairs ? (i & 1) : 0;
        const long L = (long)ti * G + c; if (L >= nwg) return false;
        int wgid = (int)L; { const int q = nwg / NXCD, r = nwg % NXCD, xcd = wgid % NXCD, off = wgid / NXCD; wgid = (xcd < r ? xcd * (q + 1) : r * (q + 1) + (xcd - r) * q) + off; }
        const int nig = WGM * nN, gid = wgid / nig, fm = gid * WGM, gsz = (nM - fm) < WGM ? (nM - fm) : WGM;
        u.pm = fm + ((wgid % nig) % gsz); u.pn = (wgid % nig) / gsz; return true;
    }
};

template <class Epi, class Sched, bool ALIGN_EPI>
__device__ __forceinline__ void gemm_phase(LAS unsigned char* lds, const Gemm g, const Sched& S, const Epi& E) {
    const int tid = threadIdx.x, wid = __builtin_amdgcn_readfirstlane(tid >> 6), lane = tid & 63, wr = wid >> 2, wc = wid & 3, fr = lane & 15, fq = lane >> 4;
    const int K = g.K, nt = K / BK;
    unsigned voffA[2], voffB[2];
#pragma unroll
    for (int i = 0; i < 2; ++i) { int R, C; stage_rc(tid * 16 + i * 8192, R, C); voffA[i] = (unsigned)(R * g.lda + C) * 2u; voffB[i] = (unsigned)(R * g.ldb + C) * 2u; }
    const size_t kstep = (size_t)(BK * 2);
    const size_t hstepA = (size_t)HALF * g.lda * 2, hstepB = (size_t)HALF * g.ldb * 2;
    const size_t tstepA = 2 * hstepA, tstepB = 2 * hstepB;
    const unsigned ldsw = (unsigned)wid * 1024u;
    const int aoff = lds_byte(wr * 64 + fr, fq * 8), boff = lds_byte(wc * 32 + fr, fq * 8);
#define PG8_SA(b, h) (((b) * 2 + (h)) * HTB)
#define PG8_SB(b, h) ((4 + (b) * 2 + (h)) * HTB)
#define PG8_STAGE(bufoff, gbase, voff) do { _Pragma("unroll") for (int _i = 0; _i < 2; ++_i) \
        __builtin_amdgcn_global_load_lds((const unsigned*)((const char*)(gbase) + (voff)[_i]), (LAS unsigned*)(lds + (bufoff) + ldsw + _i * 8192), 16, 0, 0); } while (0)
#define PG8_LDA(dst, b, h) do { _Pragma("unroll") for (int m = 0; m < 4; ++m) _Pragma("unroll") for (int k = 0; k < 2; ++k) dst[m][k] = *(const LAS bf16x8*)(lds + PG8_SA(b, h) + aoff + m * 2048 + k * 1024); } while (0)
#define PG8_LDB(dst, b, h) do { _Pragma("unroll") for (int n = 0; n < 2; ++n) _Pragma("unroll") for (int k = 0; k < 2; ++k) dst[n][k] = *(const LAS bf16x8*)(lds + PG8_SB(b, h) + boff + n * 2048 + k * 1024); } while (0)
#define PG8_MMA(ai, bj, At, Bt) do { __builtin_amdgcn_s_setprio(1); _Pragma("unroll") for (int m = 0; m < 4; ++m) _Pragma("unroll") for (int n = 0; n < 2; ++n) _Pragma("unroll") for (int k = 0; k < 2; ++k) \
        acc[ai][bj][m][n] = __builtin_amdgcn_mfma_f32_16x16x32_bf16(Bt[n][k], At[m][k], acc[ai][bj][m][n], 0, 0, 0); __builtin_amdgcn_s_setprio(0); } while (0)
#define PG8_WAIT_V(n) asm volatile("s_waitcnt vmcnt(" #n ")" ::: "memory")
#define PG8_WAIT_L(n) asm volatile("s_waitcnt lgkmcnt(" #n ")" ::: "memory")
#define PG8_BAR __builtin_amdgcn_s_barrier()
#define PG8_SCHED __builtin_amdgcn_sched_barrier(0)
    Unit cur, nxt; int ui = 0;
    if (!S.next(0, cur)) return;
    f32x4 acc[2][2][4][2];
#pragma unroll
    for (int a = 0; a < 2; ++a)
#pragma unroll
        for (int b = 0; b < 2; ++b)
#pragma unroll
            for (int m = 0; m < 4; ++m)
#pragma unroll
                for (int n = 0; n < 2; ++n) acc[a][b][m][n] = (f32x4){0.f, 0.f, 0.f, 0.f};
    bf16x8 At[4][2], B0[2][2], B1[2][2];
    const char* cA = (const char*)g.A + (size_t)cur.pm * tstepA + (cur.br ? g.a_br : 0); const char* cB = (const char*)g.Bt + (size_t)cur.pn * tstepB + (cur.br ? g.b_br : 0);
    PG8_STAGE(PG8_SB(0, 0), cB, voffB); PG8_STAGE(PG8_SB(0, 1), cB + hstepB, voffB); PG8_STAGE(PG8_SA(0, 0), cA, voffA); PG8_STAGE(PG8_SA(0, 1), cA + hstepA, voffA);
    if (wr == 1) PG8_BAR;
    PG8_WAIT_V(2); PG8_BAR;
    PG8_STAGE(PG8_SB(1, 0), cB + kstep, voffB); PG8_STAGE(PG8_SA(1, 0), cA + kstep, voffA); PG8_STAGE(PG8_SB(1, 1), cB + hstepB + kstep, voffB);
    PG8_WAIT_V(6); PG8_BAR;
    for (;;) {
        const bool has_next = S.next(ui + 1, nxt);
        const char* nA = has_next ? (const char*)g.A + (size_t)nxt.pm * tstepA + (nxt.br ? g.a_br : 0) : cA; const char* nB = has_next ? (const char*)g.Bt + (size_t)nxt.pn * tstepB + (nxt.br ? g.b_br : 0) : cB;
        for (int t = 0; t < nt; t += 2) {
            const bool last = (t == nt - 2);
            const char* a1 = cA + (size_t)(t + 1) * kstep;
            const char* a2 = last ? nA : cA + (size_t)(t + 2) * kstep; const char* b2 = last ? nB : cB + (size_t)(t + 2) * kstep;
            const char* a3 = a2 + kstep; const char* b3 = b2 + kstep;
            PG8_LDB(B0, 0, 0); PG8_LDB(B1, 0, 1); PG8_SCHED; PG8_LDA(At, 0, 0); PG8_STAGE(PG8_SA(1, 1), a1 + hstepA, voffA);
            PG8_WAIT_V(8); PG8_WAIT_L(0); PG8_BAR; PG8_MMA(0, 0, At, B0); PG8_MMA(0, 1, At, B1); PG8_BAR; PG8_SCHED;
            PG8_LDA(At, 0, 1); PG8_STAGE(PG8_SB(0, 0), b2, voffB); PG8_STAGE(PG8_SB(0, 1), b2 + hstepB, voffB); PG8_STAGE(PG8_SA(0, 0), a2, voffA);
            PG8_WAIT_V(8); PG8_WAIT_L(0); PG8_BAR; PG8_MMA(1, 0, At, B0); PG8_MMA(1, 1, At, B1); PG8_BAR; PG8_SCHED;
            PG8_LDB(B0, 1, 0); PG8_LDB(B1, 1, 1); PG8_SCHED; PG8_LDA(At, 1, 0); PG8_STAGE(PG8_SA(0, 1), a2 + hstepA, voffA);
            PG8_WAIT_V(8); PG8_WAIT_L(0); PG8_BAR; PG8_MMA(0, 0, At, B0); PG8_MMA(0, 1, At, B1); PG8_BAR; PG8_SCHED;
            PG8_LDA(At, 1, 1); PG8_STAGE(PG8_SB(1, 0), b3, voffB); PG8_STAGE(PG8_SB(1, 1), b3 + hstepB, voffB); PG8_STAGE(PG8_SA(1, 0), a3, voffA);
            PG8_WAIT_V(8); PG8_WAIT_L(0); PG8_BAR; PG8_MMA(1, 0, At, B0); PG8_MMA(1, 1, At, B1); PG8_BAR; PG8_SCHED;
        }
        if constexpr (ALIGN_EPI) { if (wr == 0) PG8_BAR; }
        E(acc, cur, wr, wc, fr, fq);
        if (!has_next) break;
        if (!E.keep(cur)) {
#pragma unroll
            for (int a = 0; a < 2; ++a)
#pragma unroll
                for (int b = 0; b < 2; ++b)
#pragma unroll
                    for (int m = 0; m < 4; ++m)
#pragma unroll
                        for (int n = 0; n < 2; ++n) acc[a][b][m][n] = (f32x4){0.f, 0.f, 0.f, 0.f};
        }
        cur = nxt; cA = nA; cB = nB; ++ui;
        if constexpr (ALIGN_EPI) { if (wr == 1) PG8_BAR; }
    }
    PG8_WAIT_V(0);
    if constexpr (!ALIGN_EPI) { if (wr == 0) PG8_BAR; }
    PG8_BAR;
#undef PG8_SA
#undef PG8_SB
#undef PG8_STAGE
#undef PG8_LDA
#undef PG8_LDB
#undef PG8_MMA
#undef PG8_WAIT_V
#undef PG8_WAIT_L
#undef PG8_BAR
#undef PG8_SCHED
}

typedef f32x4 Acc[2][2][4][2];

struct EpiP1 {
    bf16_t* PROJ; bf16_t* GATES; const float* b_gate; const float* qn; const float* kn; const float* tab;
    __device__ __forceinline__ bool keep(const Unit&) const { return false; }
    __device__ __forceinline__ void operator()(Acc& acc, const Unit& u, int wr, int wc, int fr, int fq) const {
        const int row0 = u.pm * BM + wr * 64 + fr;
#if DBG_PLAIN
        {
#pragma unroll
            for (int ai = 0; ai < 2; ++ai)
#pragma unroll
                for (int m = 0; m < 4; ++m) { const size_t row = (size_t)(row0 + ai * HALF + m * 16);
                    bf16_t* rowp = (u.pn >= 6) ? GATES + row * NGATE + 256 * (u.pn - 6) + 64 * wc + 4 * fq : PROJ + row * NPROJ + 256 * u.pn + 64 * wc + 4 * fq;
#pragma unroll
                    for (int bj = 0; bj < 2; ++bj)
#pragma unroll
                        for (int n = 0; n < 2; ++n) { const f32x4 v = acc[ai][bj][m][n]; u32x2 w; w.x = pk2(v[0], v[1]); w.y = pk2(v[2], v[3]); *(u32x2*)(rowp + 32 * bj + 16 * n) = w; } }
            return;
        }
#endif
        if (u.pn >= 6) {
            const int gb = 256 * (u.pn - 6) + 64 * wc + 4 * fq;
            f32x4 bv[2][2];
#pragma unroll
            for (int bj = 0; bj < 2; ++bj)
#pragma unroll
                for (int n = 0; n < 2; ++n) bv[bj][n] = *(const f32x4*)(b_gate + gb + 32 * bj + 16 * n);
#pragma unroll
            for (int ai = 0; ai < 2; ++ai)
#pragma unroll
                for (int m = 0; m < 4; ++m) { bf16_t* rowp = GATES + (size_t)(row0 + ai * HALF + m * 16) * NGATE + gb;
#pragma unroll
                    for (int bj = 0; bj < 2; ++bj)
#pragma unroll
                        for (int n = 0; n < 2; ++n) { const f32x4 v = acc[ai][bj][m][n] + bv[bj][n]; f32x4 s;
#pragma unroll
                            for (int j = 0; j < 4; ++j) s[j] = __builtin_amdgcn_rcpf(1.0f + __builtin_amdgcn_exp2f(-LOG2E * v[j]));
                            u32x2 w; w.x = cvt_pk_bf16(s[0], s[1]); w.y = cvt_pk_bf16(s[2], s[3]); *(u32x2*)(rowp + 32 * bj + 16 * n) = w; } }
            return;
        }
        const int Lb = 256 * u.pn + 64 * wc;
        const bool isQA = Lb < 512, isKA = (Lb >= 512 && Lb < 640), isQB = (Lb >= 768 && Lb < 1280);
        if (isQA || isKA) {
            const float* gain = isQA ? qn : kn; const float osc = isQA ? C2 : 1.0f;
            f32x4 gv[2][2];
#pragma unroll
            for (int bj = 0; bj < 2; ++bj)
#pragma unroll
                for (int n = 0; n < 2; ++n) gv[bj][n] = *(const f32x4*)(gain + 32 * bj + 16 * n + 4 * fq);
#pragma unroll
            for (int ai = 0; ai < 2; ++ai)
#pragma unroll
                for (int m = 0; m < 4; ++m) { const int row = row0 + ai * HALF + m * 16; float ss = 0.f;
#pragma unroll
                    for (int bj = 0; bj < 2; ++bj)
#pragma unroll
                        for (int n = 0; n < 2; ++n) { const f32x4 x = acc[ai][bj][m][n]; ss += (x[0] * x[0] + x[1] * x[1]) + (x[2] * x[2] + x[3] * x[3]); }
                    ss += __shfl_xor(ss, 16); ss += __shfl_xor(ss, 32);
                    const float rinv = osc * __builtin_amdgcn_rsqf(ss * (1.0f / 64.0f) + EPS);
                    const int t = row & seq_mask(row); bf16_t* rowp = PROJ + (size_t)row * NPROJ + Lb + 4 * fq;
#pragma unroll
                    for (int bj = 0; bj < 2; ++bj) { const int pos = bj ? (t & 63) : (t >> 6);
                        const f32x4 c4 = *(const f32x4*)(tab + pos * 16 + 4 * fq), s4 = *(const f32x4*)(tab + 1024 + pos * 16 + 4 * fq);
                        const f32x4 lo = acc[ai][bj][m][0] * gv[bj][0] * rinv, hi = acc[ai][bj][m][1] * gv[bj][1] * rinv;
                        const f32x4 ylo = lo * c4 - hi * s4, yhi = hi * c4 + lo * s4;
                        u32x2 w; w.x = cvt_pk_bf16(ylo[0], ylo[1]); w.y = cvt_pk_bf16(ylo[2], ylo[3]); *(u32x2*)(rowp + 32 * bj) = w;
                        w.x = cvt_pk_bf16(yhi[0], yhi[1]); w.y = cvt_pk_bf16(yhi[2], yhi[3]); *(u32x2*)(rowp + 32 * bj + 16) = w; } }
        } else {
            const float osc = isQB ? C2 : 1.0f;
#pragma unroll
            for (int ai = 0; ai < 2; ++ai)
#pragma unroll
                for (int m = 0; m < 4; ++m) { bf16_t* rowp = PROJ + (size_t)(row0 + ai * HALF + m * 16) * NPROJ + Lb + 4 * fq;
#pragma unroll
                    for (int bj = 0; bj < 2; ++bj)
#pragma unroll
                        for (int n = 0; n < 2; ++n) { const f32x4 v = acc[ai][bj][m][n] * osc; u32x2 w; w.x = cvt_pk_bf16(v[0], v[1]); w.y = cvt_pk_bf16(v[2], v[3]); *(u32x2*)(rowp + 32 * bj + 16 * n) = w; } }
        }
    }
};

struct EpiBranch {
    const bf16_t* GATES; bf16_t* MIX;
    __device__ __forceinline__ bool keep(const Unit& u) const { return u.br == 0; }
    __device__ __forceinline__ void operator()(Acc& acc, const Unit& u, int wr, int wc, int fr, int fq) const {
        const int row0 = u.pm * BM + wr * 64 + fr, cb = u.pn * BM + wc * 32 + 8 * fq;
#pragma unroll
        for (int ai = 0; ai < 2; ++ai)
#pragma unroll
            for (int m = 0; m < 4; ++m) { const size_t row = (size_t)(row0 + ai * HALF + m * 16);
#pragma unroll
                for (int bj = 0; bj < 2; ++bj) {
                    const u32x4 gbw = *(const u32x4*)(GATES + row * NGATE + 1024 + cb + bj * HALF);
                    float gb[8]; gb[0] = bf_lo(gbw.x); gb[1] = bf_hi(gbw.x); gb[2] = bf_lo(gbw.y); gb[3] = bf_hi(gbw.y); gb[4] = bf_lo(gbw.z); gb[5] = bf_hi(gbw.z); gb[6] = bf_lo(gbw.w); gb[7] = bf_hi(gbw.w);
                    if (u.br == 0) {
                        const u32x4 gaw = *(const u32x4*)(GATES + row * NGATE + cb + bj * HALF);
                        float ga[8]; ga[0] = bf_lo(gaw.x); ga[1] = bf_hi(gaw.x); ga[2] = bf_lo(gaw.y); ga[3] = bf_hi(gaw.y); ga[4] = bf_lo(gaw.z); ga[5] = bf_hi(gaw.z); ga[6] = bf_lo(gaw.w); ga[7] = bf_hi(gaw.w);
#pragma unroll
                        for (int n = 0; n < 2; ++n)
#pragma unroll
                            for (int j = 0; j < 4; ++j) acc[ai][bj][m][n][j] *= ga[4 * n + j] * __builtin_amdgcn_rcpf(__builtin_fmaxf(gb[4 * n + j], 1e-30f));
                    } else {
                        f32x4 v0, v1;
#pragma unroll
                        for (int j = 0; j < 4; ++j) { v0[j] = acc[ai][bj][m][0][j] * gb[j]; v1[j] = acc[ai][bj][m][1][j] * gb[4 + j]; }
                        u32x4 w; w.x = cvt_pk_bf16(v0[0], v0[1]); w.y = cvt_pk_bf16(v0[2], v0[3]); w.z = cvt_pk_bf16(v1[0], v1[1]); w.w = cvt_pk_bf16(v1[2], v1[3]);
                        *(u32x4*)(MIX + row * DM + cb + bj * HALF) = w;
                    } } }
    }
};
struct EpiNormOut {
    bf16_t* OUT; float* SS;
    __device__ __forceinline__ bool keep(const Unit&) const { return false; }
    __device__ __forceinline__ void operator()(Acc& acc, const Unit& u, int wr, int wc, int fr, int fq) const {
        const int row0 = u.pm * BM + wr * 64 + fr, cb = u.pn * BM + wc * 32 + 8 * fq;
#pragma unroll
        for (int ai = 0; ai < 2; ++ai)
#pragma unroll
            for (int m = 0; m < 4; ++m) { const size_t row = (size_t)(row0 + ai * HALF + m * 16); float ss = 0.f;
#pragma unroll
                for (int bj = 0; bj < 2; ++bj) { const f32x4 v0 = acc[ai][bj][m][0], v1 = acc[ai][bj][m][1];
                    ss += (v0[0] * v0[0] + v0[1] * v0[1]) + (v0[2] * v0[2] + v0[3] * v0[3]) + (v1[0] * v1[0] + v1[1] * v1[1]) + (v1[2] * v1[2] + v1[3] * v1[3]);
                    u32x4 w; w.x = cvt_pk_bf16(v0[0], v0[1]); w.y = cvt_pk_bf16(v0[2], v0[3]); w.z = cvt_pk_bf16(v1[0], v1[1]); w.w = cvt_pk_bf16(v1[2], v1[3]);
                    *(u32x4*)(OUT + row * DM + cb + bj * HALF) = w; }
                ss += __shfl_xor(ss, 16); ss += __shfl_xor(ss, 32);
                if (fq == 0) SS[row * 16 + u.pn * 4 + wc] = ss; }
    }
};
struct EpiSwiGLU {
    bf16_t* ACT;
    __device__ __forceinline__ bool keep(const Unit&) const { return false; }
    __device__ __forceinline__ void operator()(Acc& acc, const Unit& u, int wr, int wc, int fr, int fq) const {
        const int row0 = u.pm * BM + wr * 64 + fr, cb = u.pn * HALF + wc * 32 + 8 * fq;
#pragma unroll
        for (int ai = 0; ai < 2; ++ai)
#pragma unroll
            for (int m = 0; m < 4; ++m) { const size_t row = (size_t)(row0 + ai * HALF + m * 16); f32x4 a[2];
#pragma unroll
                for (int n = 0; n < 2; ++n)
#pragma unroll
                    for (int j = 0; j < 4; ++j) { const float gt = acc[ai][0][m][n][j], up = acc[ai][1][m][n][j];
                        a[n][j] = gt * __builtin_amdgcn_rcpf(1.0f + __builtin_amdgcn_exp2f(-LOG2E * gt)) * up; }
                u32x4 w; w.x = cvt_pk_bf16(a[0][0], a[0][1]); w.y = cvt_pk_bf16(a[0][2], a[0][3]); w.z = cvt_pk_bf16(a[1][0], a[1][1]); w.w = cvt_pk_bf16(a[1][2], a[1][3]);
                *(u32x4*)(ACT + row * DFF + cb) = w; }
    }
};
}

#define XB_TMO      128
#define XB_XCNT(j)  (256  + 64 * (j))
#define XB_XSUB(j)  (1280 + 64 * (j))
#define XB_XGEN(j)  (2304 + 64 * (j))
#define XB_TOP      3328
#define XB_TOPGEN   3392
#define XCD_BAR_WORDS 3456
#define XB_SPIN_CAP (1u << 18)
constexpr int CW_BAR = 4096;

__device__ __forceinline__ unsigned xb_ld(unsigned* p)              { return __hip_atomic_load(p, __ATOMIC_RELAXED, __HIP_MEMORY_SCOPE_AGENT); }
__device__ __forceinline__ unsigned xb_add(unsigned* p, unsigned v) { return __hip_atomic_fetch_add(p, v, __ATOMIC_RELAXED, __HIP_MEMORY_SCOPE_AGENT); }
__device__ __forceinline__ unsigned xb_xcc_id() { return (unsigned)__builtin_amdgcn_s_getreg((3 << 11) | 20) & 0xFu; }
#define XB_SPIN(cond, bar) do { unsigned _sp = 0; while (cond) { __builtin_amdgcn_s_sleep(1); \
    if ((++_sp & 255u) == 0u) { if (xb_ld(&(bar)[XB_TMO])) break; if (_sp > XB_SPIN_CAP) { atomicAdd(&(bar)[XB_TMO], 1u); break; } } } } while (0)

struct XcdBarrier { unsigned* bar; unsigned x; volatile LAS unsigned* st; };

__device__ __forceinline__ XcdBarrier xcd_barrier_post(unsigned* bar, volatile LAS unsigned* st) {
    XcdBarrier b; b.bar = bar; b.x = xb_xcc_id(); b.st = st;
    if (threadIdx.x == 0) (void)xb_add(&bar[XB_XCNT(b.x)], 1u);
    return b;
}
__device__ __forceinline__ void xcd_barrier_complete(unsigned* bar, unsigned x, unsigned& nloc, unsigned& nx) {
    const unsigned G = gridDim.x * gridDim.y * gridDim.z;
    unsigned sum, cnt, mine, sp = 0u;
    for (;;) {
        sum = 0u; cnt = 0u; mine = 0u;
#pragma unroll
        for (unsigned j = 0; j < 16; ++j) { const unsigned c = xb_ld(&bar[XB_XCNT(j)]); sum += c; cnt += (c > 0u) ? 1u : 0u; mine = (j == x) ? c : mine; }
        if (sum == G) break;
        __builtin_amdgcn_s_sleep(1);
        if ((++sp & 255u) == 0u) { if (xb_ld(&bar[XB_TMO])) break; if (sp > XB_SPIN_CAP) { atomicAdd(&bar[XB_TMO], 1u); break; } }
    }
    nloc = mine > 0u ? mine : 1u; nx = cnt > 0u ? cnt : 1u;
}
__device__ __forceinline__ void xcd_barrier(const XcdBarrier& b) {
    asm volatile("s_waitcnt vmcnt(0)" ::: "memory");
    __syncthreads();
    if (threadIdx.x == 0) {
        unsigned* bar = b.bar;
        __builtin_amdgcn_s_waitcnt(0);
        unsigned nloc = b.st[0], nx = b.st[1];
        if (nloc == 0u) { xcd_barrier_complete(bar, b.x, nloc, nx); b.st[0] = nloc; b.st[1] = nx; }
        const unsigned old = xb_add(&bar[XB_XSUB(b.x)], 1u);
        const unsigned gen = old / nloc;
        if (old + 1u == (gen + 1u) * nloc) {
            __builtin_amdgcn_fence(__ATOMIC_RELEASE, "agent");
            asm volatile("s_waitcnt vmcnt(0)" ::: "memory");
            const unsigned og = xb_add(&bar[XB_TOP], 1u);
            const unsigned tg = og / nx;
            if (og + 1u == (tg + 1u) * nx) xb_add(&bar[XB_TOPGEN], 1u);
            else XB_SPIN(xb_ld(&bar[XB_TOPGEN]) == tg, bar);
            __builtin_amdgcn_fence(__ATOMIC_ACQUIRE, "agent");
            xb_add(&bar[XB_XGEN(b.x)], 1u);
            asm volatile("s_waitcnt vmcnt(0)" ::: "memory");
        } else {
            XB_SPIN(xb_ld(&bar[XB_XGEN(b.x)]) == gen, bar);
            __builtin_amdgcn_fence(__ATOMIC_ACQUIRE, "agent");
            asm volatile("s_waitcnt vmcnt(0)" ::: "memory");
        }
    }
    __syncthreads();
}

struct Args { const float* in[19]; float* out; unsigned char* ws; int ph_lo, ph_hi; };

__device__ __forceinline__ const float* xrow(const Args& a, int m) { return m < MP ? a.in[0] + (size_t)m * DM : a.in[1] + (size_t)(m - MP) * DM; }

__device__ __forceinline__ int rho32(int q) { return 16 * ((q >> 2) & 1) + 4 * (q >> 3) + (q & 3); }
__device__ __forceinline__ int map_p1(int L) { return (L & ~255) + 128 * ((L >> 5) & 1) + 32 * ((L >> 6) & 3) + (L & 31); }
__device__ __forceinline__ int map_perm(int c) { return (c & ~31) + rho32(c & 31); }
__device__ __forceinline__ int map_gu(int c, int g) { return 256 * (c >> 7) + 128 * g + 32 * ((c >> 5) & 3) + rho32(c & 31); }
template <int MAP> __device__ __forceinline__ void p0_transpose_item(const float* W, int K, int N, bf16_t* WT, int lofs, LAS float* scr, int item, int lane) {
    const int nblk = N / 32, kb = item / nblk, nb = item % nblk, k0 = 64 * kb, n0 = 32 * nb;
#pragma unroll 8
    for (int i = 0; i < 32; ++i) { const int kk = 2 * i + (lane >> 5); scr[kk * 33 + (lane & 31)] = W[(size_t)(k0 + kk) * N + n0 + (lane & 31)]; }
    LDS_WAIT(); asm volatile("" ::: "memory");
    const int c = lane & 7;
#pragma unroll
    for (int j = 0; j < 4; ++j) { const int n = (lane >> 3) + 8 * j; const LAS float* s = scr + (8 * c) * 33 + n;
        u32x4 o; o.x = pk2(s[0 * 33], s[1 * 33]); o.y = pk2(s[2 * 33], s[3 * 33]); o.z = pk2(s[4 * 33], s[5 * 33]); o.w = pk2(s[6 * 33], s[7 * 33]);
        const int sc = n0 + n;
        const int dr = MAP == 0 ? map_p1(lofs + sc) : MAP == 1 ? map_perm(sc) : MAP == 2 ? map_gu(sc, 0) : map_gu(sc, 1);
        *(u32x4*)(WT + (size_t)dr * K + k0 + 8 * c) = o; }
    LDS_WAIT(); asm volatile("" ::: "memory");
}
__device__ __forceinline__ int t5_bucket(int rel) {
    const int n = rel < 0 ? -rel : rel;
    const int large = 8 + (n >= 12) + (n >= 16) + (n >= 23) + (n >= 32) + (n >= 46) + (n >= 64) + (n >= 91);
    return (rel > 0 ? 16 : 0) + (n < 8 ? n : large);
}
__device__ __forceinline__ void rms_row_to_bf16(const float* xr_, const float* gain, bf16_t* orow, int lane) {
    const f32x4* xr = (const f32x4*)xr_ + lane; const f32x4* gr = (const f32x4*)gain + lane;
    f32x4 v[4]; float s = 0.f;
#pragma unroll
    for (int j = 0; j < 4; ++j) { v[j] = xr[64 * j]; s += (v[j].x * v[j].x + v[j].y * v[j].y) + (v[j].z * v[j].z + v[j].w * v[j].w); }
    const float rs = __builtin_amdgcn_rsqf(wave_sum(s) * (1.f / DM) + EPS);
    unsigned long long* o8 = (unsigned long long*)orow + lane;
#pragma unroll
    for (int j = 0; j < 4; ++j) { const f32x4 g = gr[64 * j];
        o8[64 * j] = (unsigned long long)pk2(v[j].x * rs * g.x, v[j].y * rs * g.y) | ((unsigned long long)pk2(v[j].z * rs * g.z, v[j].w * rs * g.w) << 32); }
}
__device__ __forceinline__ void p0_prologue(const Args& a, LAS unsigned char* lds, int vcu, int G, int wave, int lane) {
    LAS float* scr = (LAS float*)(lds + wave * 16384);
    unsigned char* ws = a.ws;
    const int gw = vcu * NWAVES + wave, NGW = G * NWAVES;
    constexpr int I_IN = 16 * 48, I_GT = 16 * 64, I_A = 8 * 32, I_B = 8 * 32, I_O = 16 * 32, I_FG = 16 * 88, I_FU = 16 * 88, I_FD = 44 * 32;
    constexpr int NITEMS = I_IN + I_GT + I_A + I_B + I_O + I_FG + I_FU + I_FD;
    for (int it = gw; it < NITEMS; it += NGW) {
        int r = it;
        if (r < I_IN) { p0_transpose_item<0>(a.in[4], 1024, NPROJ, (bf16_t*)(ws + WS_WCAT1), 0, scr, r, lane); continue; } r -= I_IN;
        if (r < I_GT) { p0_transpose_item<0>(a.in[11], 1024, NGATE, (bf16_t*)(ws + WS_WCAT1), NPROJ, scr, r, lane); continue; } r -= I_GT;
        if (r < I_A) { p0_transpose_item<1>(a.in[9], 512, 1024, (bf16_t*)(ws + WS_WA), 0, scr, r, lane); continue; } r -= I_A;
        if (r < I_B) { p0_transpose_item<1>(a.in[10], 512, 1024, (bf16_t*)(ws + WS_WB), 0, scr, r, lane); continue; } r -= I_B;
        if (r < I_O) { p0_transpose_item<1>(a.in[13], 1024, 1024, (bf16_t*)(ws + WS_WOUT), 0, scr, r, lane); continue; } r -= I_O;
        if (r < I_FG) { p0_transpose_item<2>(a.in[16], 1024, DFF, (bf16_t*)(ws + WS_WGU), 0, scr, r, lane); continue; } r -= I_FG;
        if (r < I_FU) { p0_transpose_item<3>(a.in[17], 1024, DFF, (bf16_t*)(ws + WS_WGU), 0, scr, r, lane); continue; } r -= I_FU;
        p0_transpose_item<1>(a.in[18], DFF, 1024, (bf16_t*)(ws + WS_WDN), 0, scr, r, lane);
    }
    float* tab = (float*)(ws + WS_TAB);
    const int gt = gw * 64 + lane;
    if (gt < 1024) { const int pos = gt >> 4, idx = gt & 15; const float inv = 1.0f / powf(10000.0f, (float)idx * (1.0f / 16.0f)); const float ang = (float)pos * inv;
        tab[TAB_COS / 4 + gt] = cosf(ang); tab[TAB_SIN / 4 + gt] = sinf(ang); }
    else if (gt < 1024 + 8 * 260) { const int e = gt - 1024, h = e / 260, i = e % 260; const int rel = i - 128;
        tab[TAB_BT / 4 + e] = (i <= 256) ? a.in[8][t5_bucket(rel) * 8 + h] * LOG2E : 0.f; }
    else if (gt < 1024 + 8 * 260 + 8) { const int h = gt - 1024 - 8 * 260; tab[TAB_SINK / 4 + h] = a.in[7][h] * LOG2E; }
    bf16_t* H = (bf16_t*)(ws + WS_R1);
    for (int m = gw; m < M; m += NGW) rms_row_to_bf16(xrow(a, m), a.in[2], H + (size_t)m * DM, lane);
}

template <bool WIN> __device__ __forceinline__ void attn_valu_item(const Args& a, LAS unsigned char* lds, int item, int tid) {
    const bf16_t* PROJ = (const bf16_t*)(a.ws + WS_PROJ); bf16_t* Y = (bf16_t*)(a.ws + WS_R1); const float* tab = (const float*)(a.ws + WS_TAB);
    LAS float* Ks = (LAS float*)lds; LAS float* Vs = (LAS float*)(lds + 16384); LAS float* BTs = (LAS float*)(lds + 32768);
    const int rb = item >> 1, kvh = item & 1, m0 = rb * 128;
    const int smask = seq_mask(m0), S = smask + 1, sbase = m0 & ~smask, t0 = m0 - sbase;
    const int qi = tid & 127, g = tid >> 7, h = kvh * 4 + g, m = m0 + qi, tq = t0 + qi;
    const int qcol = (WIN ? 768 : 0) + h * 64, kcol = (WIN ? 1280 : 512) + kvh * 64, vcol = (WIN ? 1408 : 640) + kvh * 64;
    float q[64], o[64];
    { const u32x4* qp = (const u32x4*)(PROJ + (size_t)m * NPROJ + qcol);
#pragma unroll
      for (int c = 0; c < 8; ++c) { const u32x4 w = qp[c]; q[8 * c] = bf_lo(w.x); q[8 * c + 1] = bf_hi(w.x); q[8 * c + 2] = bf_lo(w.y); q[8 * c + 3] = bf_hi(w.y); q[8 * c + 4] = bf_lo(w.z); q[8 * c + 5] = bf_hi(w.z); q[8 * c + 6] = bf_lo(w.w); q[8 * c + 7] = bf_hi(w.w); } }
#pragma unroll
    for (int d = 0; d < 64; ++d) o[d] = 0.f;
    float mx = WIN ? tab[TAB_SINK / 4 + h] : -1e30f, l = WIN ? 1.0f : 0.0f;
    __syncthreads();
    if (WIN) { for (int i = tid; i < 4 * 260; i += 512) BTs[i] = tab[TAB_BT / 4 + (kvh * 4) * 260 + i]; }
    const int k_lo = WIN ? (t0 >= 128 ? t0 - 128 : 0) : 0, k_hi = WIN ? (t0 + 256 <= S ? t0 + 256 : S) : S;
    for (int kt = k_lo; kt < k_hi; kt += 64) {
        __syncthreads();
        { const int key = tid >> 3, ch = tid & 7; const size_t rowo = (size_t)(sbase + kt + key) * NPROJ;
          const u32x4 kw = *(const u32x4*)(PROJ + rowo + kcol + ch * 8), vw = *(const u32x4*)(PROJ + rowo + vcol + ch * 8);
          LAS f32x4* kd = (LAS f32x4*)(Ks + key * 64 + ch * 8); LAS f32x4* vd = (LAS f32x4*)(Vs + key * 64 + ch * 8);
          kd[0] = (f32x4){bf_lo(kw.x), bf_hi(kw.x), bf_lo(kw.y), bf_hi(kw.y)}; kd[1] = (f32x4){bf_lo(kw.z), bf_hi(kw.z), bf_lo(kw.w), bf_hi(kw.w)};
          vd[0] = (f32x4){bf_lo(vw.x), bf_hi(vw.x), bf_lo(vw.y), bf_hi(vw.y)}; vd[1] = (f32x4){bf_lo(vw.z), bf_hi(vw.z), bf_lo(vw.w), bf_hi(vw.w)}; }
        __syncthreads();
        for (int key = 0; key < 64; ++key) {
            const LAS f32x4* kr = (const LAS f32x4*)(Ks + key * 64);
            float s0 = 0.f, s1 = 0.f;
#pragma unroll
            for (int d4 = 0; d4 < 16; d4 += 2) { const f32x4 ka = kr[d4], kb = kr[d4 + 1];
                s0 += q[4 * d4] * ka.x + q[4 * d4 + 1] * ka.y + q[4 * d4 + 2] * ka.z + q[4 * d4 + 3] * ka.w;
                s1 += q[4 * d4 + 4] * kb.x + q[4 * d4 + 5] * kb.y + q[4 * d4 + 6] * kb.z + q[4 * d4 + 7] * kb.w; }
            float s = s0 + s1;
            if (WIN) { const int rel = kt + key - tq; const bool valid = (rel >= -128 && rel <= 128); const int bi = valid ? rel + 128 : 0;
                s += BTs[g * 260 + bi]; s = valid ? s : -1e30f; }
            if (s > mx) { const float corr = __builtin_amdgcn_exp2f(mx - s); l *= corr;
#pragma unroll
                for (int d = 0; d < 64; ++d) o[d] *= corr;
                mx = s; }
            const float p = __builtin_amdgcn_exp2f(s - mx); l += p;
            const LAS f32x4* vr = (const LAS f32x4*)(Vs + key * 64);
#pragma unroll
            for (int d4 = 0; d4 < 16; ++d4) { const f32x4 vv = vr[d4]; o[4 * d4] += p * vv.x; o[4 * d4 + 1] += p * vv.y; o[4 * d4 + 2] += p * vv.z; o[4 * d4 + 3] += p * vv.w; }
        }
    }
    const float rl = 1.0f / l;
    u32x4* yp = (u32x4*)(Y + (size_t)m * DM + (WIN ? 512 : 0) + h * 64);
#pragma unroll
    for (int c = 0; c < 8; ++c) { u32x4 w; w.x = pk2(o[8 * c] * rl, o[8 * c + 1] * rl); w.y = pk2(o[8 * c + 2] * rl, o[8 * c + 3] * rl); w.z = pk2(o[8 * c + 4] * rl, o[8 * c + 5] * rl); w.w = pk2(o[8 * c + 6] * rl, o[8 * c + 7] * rl); yp[c] = w; }
}
__device__ __forceinline__ void p2_attention(const Args& a, LAS unsigned char* lds, int vcu, int G, int tid) {
    for (int i = vcu; i < 256; i += G) attn_valu_item<false>(a, lds, (256 + (i >> 1)) * 2 + (i & 1), tid);
    for (int i = vcu; i < 512; i += G) attn_valu_item<false>(a, lds, i, tid);
    for (int i = vcu; i < 768; i += G) attn_valu_item<true>(a, lds, i, tid);
}

__device__ __forceinline__ void p3c_rows(const Args& a, int vcu, int G, int wave, int lane) {
    const bf16_t* U = (const bf16_t*)(a.ws + WS_R1); const float* SS = (const float*)(a.ws + WS_SS1); bf16_t* H2 = (bf16_t*)(a.ws + WS_H2);
    const f32x4* gp = (const f32x4*)a.in[3] + lane; const f32x4* gf = (const f32x4*)a.in[14] + lane;
    const int gw = vcu * NWAVES + wave, NGW = G * NWAVES;
    for (int m = gw; m < M; m += NGW) {
        const f32x4* ssp = (const f32x4*)(SS + (size_t)m * 16); const f32x4 s0 = ssp[0], s1 = ssp[1], s2 = ssp[2], s3 = ssp[3];
        const float ss = ((s0.x + s0.y) + (s0.z + s0.w)) + ((s1.x + s1.y) + (s1.z + s1.w)) + ((s2.x + s2.y) + (s2.z + s2.w)) + ((s3.x + s3.y) + (s3.z + s3.w));
        const float rs = __builtin_amdgcn_rsqf(ss * (1.f / DM) + EPS);
        const f32x4* xr = (const f32x4*)xrow(a, m) + lane; const u32x2* ur = (const u32x2*)(U + (size_t)m * DM) + lane;
        f32x4* orow = (f32x4*)(a.out + (size_t)m * DM) + lane;
        f32x4 v[4]; float sq = 0.f;
#pragma unroll
        for (int j = 0; j < 4; ++j) { const f32x4 x = xr[64 * j]; const u32x2 uw = ur[64 * j]; const f32x4 g = gp[64 * j];
            v[j].x = x.x + g.x * bf_lo(uw.x) * rs; v[j].y = x.y + g.y * bf_hi(uw.x) * rs; v[j].z = x.z + g.z * bf_lo(uw.y) * rs; v[j].w = x.w + g.w * bf_hi(uw.y) * rs;
            orow[64 * j] = v[j]; sq += (v[j].x * v[j].x + v[j].y * v[j].y) + (v[j].z * v[j].z + v[j].w * v[j].w); }
        const float rs2 = __builtin_amdgcn_rsqf(wave_sum(sq) * (1.f / DM) + EPS);
        unsigned long long* o8 = (unsigned long long*)(H2 + (size_t)m * DM) + lane;
#pragma unroll
        for (int j = 0; j < 4; ++j) { const f32x4 g = gf[64 * j];
            o8[64 * j] = (unsigned long long)pk2(v[j].x * rs2 * g.x, v[j].y * rs2 * g.y) | ((unsigned long long)pk2(v[j].z * rs2 * g.z, v[j].w * rs2 * g.w) << 32); }
    }
}
__device__ __forceinline__ void p6_rows(const Args& a, int vcu, int G, int wave, int lane) {
    const bf16_t* Fb = (const bf16_t*)(a.ws + WS_F); const float* SS = (const float*)(a.ws + WS_SS2);
    const f32x4* gp = (const f32x4*)a.in[15] + lane;
    const int gw = vcu * NWAVES + wave, NGW = G * NWAVES;
    for (int m = gw; m < M; m += NGW) {
        const f32x4* ssp = (const f32x4*)(SS + (size_t)m * 16); const f32x4 s0 = ssp[0], s1 = ssp[1], s2 = ssp[2], s3 = ssp[3];
        const float ss = ((s0.x + s0.y) + (s0.z + s0.w)) + ((s1.x + s1.y) + (s1.z + s1.w)) + ((s2.x + s2.y) + (s2.z + s2.w)) + ((s3.x + s3.y) + (s3.z + s3.w));
        const float rs = __builtin_amdgcn_rsqf(ss * (1.f / DM) + EPS);
        const u32x2* fr = (const u32x2*)(Fb + (size_t)m * DM) + lane; f32x4* orow = (f32x4*)(a.out + (size_t)m * DM) + lane;
#pragma unroll
        for (int j = 0; j < 4; ++j) { f32x4 x = orow[64 * j]; const u32x2 fw = fr[64 * j]; const f32x4 g = gp[64 * j];
            x.x += g.x * bf_lo(fw.x) * rs; x.y += g.y * bf_hi(fw.x) * rs; x.z += g.z * bf_lo(fw.y) * rs; x.w += g.w * bf_hi(fw.y) * rs; orow[64 * j] = x; }
    }
}

constexpr int N_PHASES = 9;
#ifndef DBG_STOP
#define DBG_STOP -1
#endif
__device__ __forceinline__ void dbg_dump(const Args& a, int k, int vcu, int G, int wave, int lane) {
    const int gw = vcu * NWAVES + wave, NGW = G * NWAVES;
    const unsigned char* ws = a.ws;
    for (int m = gw; m < M; m += NGW) {
        for (int j = 0; j < 16; ++j) { const int c = lane + 64 * j; float v = 0.f;
            auto B = [&](size_t off, size_t ld, int col) { return bf_lo((unsigned)((const bf16_t*)(ws + off))[(size_t)m * ld + col]); };
            if (k == 1) v = B(WS_PROJ, NPROJ, c) + B(WS_PROJ, NPROJ, 512 + c) + B(WS_GATES, NGATE, c) + B(WS_GATES, NGATE, 1024 + c);
            else if (k == 2) v = B(WS_R1, DM, c);
            else if (k == 3) v = B(WS_PROJ, DM, c);
            else if (k == 4) v = B(WS_R1, DM, c) + ((const float*)(ws + WS_SS1))[(size_t)m * 16 + (c & 15)];
            else if (k == 5) v = B(WS_H2, DM, c) + a.out[(size_t)m * DM + c];
            else if (k == 6) v = B(WS_ACT, DFF, c) + B(WS_ACT, DFF, 1024 + c) + B(WS_ACT, DFF, 2048 + (c % 768));
            else if (k == 7) v = B(WS_F, DM, c) + ((const float*)(ws + WS_SS2))[(size_t)m * 16 + (c & 15)];
            else if (k == 0) v = B(WS_R1, DM, c) + B(WS_WCAT1, DM, c) + B(WS_WGU, DM, c) + B(WS_WDN, DFF, c) + B(WS_WA, 512, c & 511) + B(WS_WOUT, DM, c) + ((const float*)(ws + WS_TAB))[(c + m) % 3100];
            a.out[(size_t)m * DM + c] = v; }
    }
}
__global__ void __launch_bounds__(NWAVES * 64, 2) enc_fwd(Args args) {
    extern __shared__ __attribute__((aligned(16))) unsigned char lds_raw[];
    LAS unsigned char* lds = (LAS unsigned char*)lds_raw;
    volatile LAS unsigned* MISC = (volatile LAS unsigned*)(lds + MISC_OFF);
    const int tid = threadIdx.x, lane = tid & 63, wave = __builtin_amdgcn_readfirstlane(tid >> 6);
    const int G = gridDim.x; const int bx = blockIdx.x; const int vcu = (G % 8 == 0) ? (bx % 8) * (G / 8) + bx / 8 : bx;
    unsigned char* ws = args.ws;
    gu32* ctl = (gu32*)(ws + WS_CTL);
    for (int u = tid; u < (LDS_BYTES - LDSCTL_OFF) / 4; u += NWAVES * 64) ((LAS unsigned*)(lds + LDSCTL_OFF))[u] = 0u;
    __syncthreads();
    XcdBarrier bar; bar.bar = (unsigned*)(ctl + CW_BAR); bar.x = 0; bar.st = nullptr;
    const int lo = args.ph_lo, hi = args.ph_hi;
    const bool multi = (hi - lo) > 1;
    if (multi) bar = xcd_barrier_post((unsigned*)(ctl + CW_BAR), MISC + 8);
#define IN(k) (lo <= (k) && (k) < hi)
#define SEAM(k) do { if (IN(k) && IN((k) + 1)) xcd_barrier(bar); } while (0)

    if (IN(0)) { p0_prologue(args, lds, vcu, G, wave, lane); SEAM(0); }

    if (IN(1)) {
        pg8::Gemm g{(const bf16_t*)(ws + WS_R1), (const bf16_t*)(ws + WS_WCAT1), DM, DM, DM, 0, 0};
        pg8::StaticOrder S; S.init(M, NCAT1, G, bx, 0);
        pg8::EpiP1 E{(bf16_t*)(ws + WS_PROJ), (bf16_t*)(ws + WS_GATES), args.in[12], args.in[5], args.in[6], (const float*)(ws + WS_TAB)};
        pg8::gemm_phase<pg8::EpiP1, pg8::StaticOrder, true>(lds, g, S, E);
        SEAM(1);
    }
    if (IN(2)) { p2_attention(args, lds, vcu, G, tid); SEAM(2); }

    if (IN(3)) {
        pg8::Gemm g{(const bf16_t*)(ws + WS_R1), (const bf16_t*)(ws + WS_WA), DM, 512, 512, 512 * 2, (size_t)(WS_WB - WS_WA)};
        pg8::StaticOrder S; S.init(M, DM, G, bx, 1);
        pg8::EpiBranch E{(const bf16_t*)(ws + WS_GATES), (bf16_t*)(ws + WS_PROJ)};
        pg8::gemm_phase<pg8::EpiBranch, pg8::StaticOrder, true>(lds, g, S, E);
        SEAM(3);
    }
    if (IN(4)) {
        pg8::Gemm g{(const bf16_t*)(ws + WS_PROJ), (const bf16_t*)(ws + WS_WOUT), DM, DM, DM, 0, 0};
        pg8::StaticOrder S; S.init(M, DM, G, bx, 0);
        pg8::EpiNormOut E{(bf16_t*)(ws + WS_R1), (float*)(ws + WS_SS1)};
        pg8::gemm_phase<pg8::EpiNormOut, pg8::StaticOrder, true>(lds, g, S, E);
        SEAM(4);
    }
    if (IN(5)) { p3c_rows(args, vcu, G, wave, lane); SEAM(5); }

    if (IN(6)) {
        pg8::Gemm g{(const bf16_t*)(ws + WS_H2), (const bf16_t*)(ws + WS_WGU), DM, DM, DM, 0, 0};
        pg8::StaticOrder S; S.init(M, NGU, G, bx, 0);
        pg8::EpiSwiGLU E{(bf16_t*)(ws + WS_ACT)};
        pg8::gemm_phase<pg8::EpiSwiGLU, pg8::StaticOrder, true>(lds, g, S, E);
        SEAM(6);
    }
    if (IN(7)) {
        pg8::Gemm g{(const bf16_t*)(ws + WS_ACT), (const bf16_t*)(ws + WS_WDN), DFF, DFF, DFF, 0, 0};
        pg8::StaticOrder S; S.init(M, DM, G, bx, 0);
        pg8::EpiNormOut E{(bf16_t*)(ws + WS_F), (float*)(ws + WS_SS2)};
        pg8::gemm_phase<pg8::EpiNormOut, pg8::StaticOrder, true>(lds, g, S, E);
        SEAM(7);
    }
    if (IN(8)) { p6_rows(args, vcu, G, wave, lane); }
    if (IN(100)) { dbg_dump(args, DBG_STOP, vcu, G, wave, lane); }
#undef IN
#undef SEAM
}

extern "C" void kernel_launch(void* const* d_in, const int* in_sizes, int n_in, void* d_out, int out_size, void* d_ws, size_t ws_size, hipStream_t stream) {
    static int grid = 0;
    if (grid == 0) {
        if (n_in != 19 || out_size != M * DM || ws_size < WS_END) { fprintf(stderr, "kernel_launch: unexpected shapes: n_in %d out %d ws %zu\n", n_in, out_size, ws_size); grid = -1; return; }
        int dev = 0, cus = 0, per_cu = 0;
        if (hipGetDevice(&dev) != hipSuccess || hipDeviceGetAttribute(&cus, hipDeviceAttributeMultiprocessorCount, dev) != hipSuccess) { grid = -1; return; }
        if (hipFuncSetAttribute((const void*)enc_fwd, hipFuncAttributeMaxDynamicSharedMemorySize, LDS_BYTES) != hipSuccess) { fprintf(stderr, "kernel_launch: hipFuncSetAttribute failed\n"); grid = -1; return; }
        if (hipOccupancyMaxActiveBlocksPerMultiprocessor(&per_cu, (const void*)enc_fwd, NWAVES * 64, LDS_BYTES) != hipSuccess || per_cu < 1)
            fprintf(stderr, "kernel_launch: note: occupancy query reports %d workgroups per CU\n", per_cu);
        (void)hipGetLastError();
        grid = cus;
    }
    if (grid < 0) return;
    if (hipMemsetAsync((char*)d_ws + WS_CTL, 0, CTL_ZERO_BYTES, stream) != hipSuccess) return;
    Args a{};
    for (int i = 0; i < 19; ++i) a.in[i] = (const float*)d_in[i];
    a.out = (float*)d_out; a.ws = (unsigned char*)d_ws;
#if MK_ONE_LAUNCH
    a.ph_lo = 0; a.ph_hi = N_PHASES;
    hipLaunchKernelGGL(enc_fwd, dim3(grid), dim3(NWAVES * 64), LDS_BYTES, stream, a);
#else
    for (int p = 0; p <= (DBG_STOP < 0 ? N_PHASES - 1 : DBG_STOP); ++p) { a.ph_lo = p; a.ph_hi = p + 1; hipLaunchKernelGGL(enc_fwd, dim3(grid), dim3(NWAVES * 64), LDS_BYTES, stream, a); }
    if (DBG_STOP >= 0) { a.ph_lo = 100; a.ph_hi = 101; hipLaunchKernelGGL(enc_fwd, dim3(grid), dim3(NWAVES * 64), LDS_BYTES, stream, a); }
#endif
}
```

```cpp
#include <hip/hip_runtime.h>
#include <cstdio>
#include <cstdint>

#define DBG_PLAIN 0
#ifndef ATT_DO_GLOBAL
#define ATT_DO_GLOBAL 1
#endif
#ifndef ATT_DO_WIN
#define ATT_DO_WIN 1
#endif
#ifndef MK_ONE_LAUNCH
#define MK_ONE_LAUNCH 1
#endif

constexpr int DM = 1024, MP = 16 * 2048, MS = 4 * 4096, M = MP + MS;
constexpr int NPROJ = 1536, NGATE = 2048, NCAT1 = NPROJ + NGATE;
constexpr int DFF = 2816, NGU = 2 * DFF;
constexpr float EPS = 1e-6f;
constexpr float LOG2E = 1.4426950408889634f;
constexpr float C2 = 0.125f * LOG2E;

constexpr size_t MiB = 1u << 20;
constexpr size_t WS_CTL = 0, CTL_ZERO_BYTES = 1 * MiB;
constexpr size_t WS_TAB = 1 * MiB;
constexpr size_t TAB_COS = 0, TAB_SIN = 4096, TAB_SINK = 8192, TAB_BTP = 16384;
constexpr size_t WS_SS1 = 2 * MiB, WS_SS2 = 5 * MiB;
constexpr size_t WS_WCAT1 = 8 * MiB, WS_WA = 15 * MiB, WS_WB = 16 * MiB, WS_WOUT = 17 * MiB, WS_WGU = 19 * MiB, WS_WDN = 30 * MiB;
constexpr size_t WS_R1 = 36 * MiB;
constexpr size_t WS_PROJ = 132 * MiB;
constexpr size_t WS_GATES = 276 * MiB;
constexpr size_t WS_H2 = 372 * MiB;
constexpr size_t WS_ACT = 36 * MiB;
constexpr size_t WS_F = 300 * MiB;
constexpr size_t WS_END = 468 * MiB;

constexpr int RING_BYTES = 131072;
constexpr int LDSCTL_OFF = RING_BYTES, MISC_OFF = LDSCTL_OFF + 320;
constexpr int LDS_BYTES = 147456;
constexpr int NWAVES = 8;

#define GAS __attribute__((address_space(1)))
#define LAS __attribute__((address_space(3)))
typedef unsigned short bf16_t;
typedef short bf16x8 __attribute__((ext_vector_type(8)));
typedef float f32x4 __attribute__((ext_vector_type(4)));
typedef float f32x2 __attribute__((ext_vector_type(2)));
typedef unsigned u32x4 __attribute__((ext_vector_type(4)));
typedef unsigned u32x2 __attribute__((ext_vector_type(2)));
typedef GAS unsigned gu32;
#define RLX_AGENT __ATOMIC_RELAXED, __HIP_MEMORY_SCOPE_AGENT
#define LDS_WAIT() asm volatile("s_waitcnt lgkmcnt(0)" ::: "memory")
#define VM_WAIT() asm volatile("s_waitcnt vmcnt(0)" ::: "memory")

__device__ __forceinline__ unsigned f2bf(float f) { unsigned u = __builtin_bit_cast(unsigned, f); return (u + 0x7fffu + ((u >> 16) & 1u)) >> 16; }
__device__ __forceinline__ unsigned pk2(float lo, float hi) { return f2bf(lo) | (f2bf(hi) << 16); }
__device__ __forceinline__ float bf_lo(unsigned w) { return __builtin_bit_cast(float, w << 16); }
__device__ __forceinline__ float bf_hi(unsigned w) { return __builtin_bit_cast(float, w & 0xffff0000u); }
typedef __bf16 bf16x2_t __attribute__((ext_vector_type(2)));
__device__ __forceinline__ unsigned cvt_pk_bf16(float lo, float hi) { f32x2 v = {lo, hi}; bf16x2_t b = __builtin_convertvector(v, bf16x2_t); return __builtin_bit_cast(unsigned, b); }
__device__ __forceinline__ float wave_sum(float v) {
#pragma unroll
    for (int o = 1; o < 64; o <<= 1) v += __shfl_xor(v, o);
    return v;
}
__device__ __forceinline__ int seq_mask(int m) { return m < MP ? 2047 : 4095; }

namespace pg8 {
constexpr int BM = 256, BK = 64, HALF = 128, HTB = HALF * BK * 2, STAGE_BYTES = 8 * HTB, NXCD = 8, WGM = 8;
__host__ __device__ __forceinline__ int lds_byte(int r, int c) { const int st = (r >> 4) * 2 + (c >> 5), rr = r & 15, cc = c & 31, ob = rr * 64 + cc * 2; return st * 1024 + (ob ^ (((ob >> 9) & 1) << 5)); }
__host__ __device__ __forceinline__ void stage_rc(int b, int& R, int& C) { const int st = b / 1024, sb = b % 1024, swz = sb ^ (((sb >> 9) & 1) << 5); R = (st >> 1) * 16 + swz / 64; C = (st & 1) * 32 + (swz % 64) / 2; }

struct Unit { int pm, pn, br; };
struct Gemm { const bf16_t* A; const bf16_t* Bt; int lda, ldb, K; size_t a_br, b_br; };

struct StaticOrder {
    int nM, nN, nwg, G, c, pairs;
    __device__ void init(int M_, int N_, int G_, int c_, int pairs_) { nM = M_ / BM; nN = N_ / BM; nwg = nM * nN; G = G_; c = c_; pairs = pairs_; }
    __device__ bool next(int i, Unit& u) const {
        const int ti = pairs ? (i >> 1) : i; u.br = pairs ? (i & 1) : 0;
        const long L = (long)ti * G + c; if (L >= nwg) return false;
        int wgid = (int)L; { const int q = nwg / NXCD, r = nwg % NXCD, xcd = wgid % NXCD, off = wgid / NXCD; wgid = (xcd < r ? xcd * (q + 1) : r * (q + 1) + (xcd - r) * q) + off; }
        const int nig = WGM * nN, gid = wgid / nig, fm = gid * WGM, gsz = (nM - fm) < WGM ? (nM - fm) : WGM;
        u.pm = fm + ((wgid % nig) % gsz); u.pn = (wgid % nig) / gsz; return true;
    }
};

template <class Epi, class Sched, bool ALIGN_EPI>
__device__ __forceinline__ void gemm_phase(LAS unsigned char* lds, const Gemm g, const Sched& S, const Epi& E) {
    const int tid = threadIdx.x, wid = __builtin_amdgcn_readfirstlane(tid >> 6), lane = tid & 63, wr = wid >> 2, wc = wid & 3, fr = lane & 15, fq = lane >> 4;
    const int K = g.K, nt = K / BK;
    unsigned voffA[2], voffB[2];
#pragma unroll
    for (int i = 0; i < 2; ++i) { int R, C; stage_rc(tid * 16 + i * 8192, R, C); voffA[i] = (unsigned)(R * g.lda + C) * 2u; voffB[i] = (unsigned)(R * g.ldb + C) * 2u; }
    const size_t kstep = (size_t)(BK * 2);
    const size_t hstepA = (size_t)HALF * g.lda * 2, hstepB = (size_t)HALF * g.ldb * 2;
    const size_t tstepA = 2 * hstepA, tstepB = 2 * hstepB;
    const unsigned ldsw = (unsigned)wid * 1024u;
    const int aoff = lds_byte(wr * 64 + fr, fq * 8), boff = lds_byte(wc * 32 + fr, fq * 8);
#define PG8_SA(b, h) (((b) * 2 + (h)) * HTB)
#define PG8_SB(b, h) ((4 + (b) * 2 + (h)) * HTB)
#define PG8_STAGE(bufoff, gbase, voff) do { _Pragma("unroll") for (int _i = 0; _i < 2; ++_i) \
        __builtin_amdgcn_global_load_lds((const unsigned*)((const char*)(gbase) + (voff)[_i]), (LAS unsigned*)(lds + (bufoff) + ldsw + _i * 8192), 16, 0, 0); } while (0)
#define PG8_LDA(dst, b, h) do { _Pragma("unroll") for (int m = 0; m < 4; ++m) _Pragma("unroll") for (int k = 0; k < 2; ++k) dst[m][k] = *(const LAS bf16x8*)(lds + PG8_SA(b, h) + aoff + m * 2048 + k * 1024); } while (0)
#define PG8_LDB(dst, b, h) do { _Pragma("unroll") for (int n = 0; n < 2; ++n) _Pragma("unroll") for (int k = 0; k < 2; ++k) dst[n][k] = *(const LAS bf16x8*)(lds + PG8_SB(b, h) + boff + n * 2048 + k * 1024); } while (0)
#define PG8_MMA(ai, bj, At, Bt) do { __builtin_amdgcn_s_setprio(1); _Pragma("unroll") for (int m = 0; m < 4; ++m) _Pragma("unroll") for (int n = 0; n < 2; ++n) _Pragma("unroll") for (int k = 0; k < 2; ++k) \
        acc[ai][bj][m][n] = __builtin_amdgcn_mfma_f32_16x16x32_bf16(Bt[n][k], At[m][k], acc[ai][bj][m][n], 0, 0, 0); __builtin_amdgcn_s_setprio(0); } while (0)
#define PG8_WAIT_V(n) asm volatile("s_waitcnt vmcnt(" #n ")" ::: "memory")
#define PG8_WAIT_L(n) asm volatile("s_waitcnt lgkmcnt(" #n ")" ::: "memory")
#define PG8_BAR __builtin_amdgcn_s_barrier()
#define PG8_SCHED __builtin_amdgcn_sched_barrier(0)
    Unit cur, nxt; int ui = 0;
    if (!S.next(0, cur)) return;
    f32x4 acc[2][2][4][2];
#pragma unroll
    for (int a = 0; a < 2; ++a)
#pragma unroll
        for (int b = 0; b < 2; ++b)
#pragma unroll
            for (int m = 0; m < 4; ++m)
#pragma unroll
                for (int n = 0; n < 2; ++n) acc[a][b][m][n] = (f32x4){0.f, 0.f, 0.f, 0.f};
    bf16x8 At[4][2], B0[2][2], B1[2][2];
    const char* cA = (const char*)g.A + (size_t)cur.pm * tstepA + (cur.br ? g.a_br : 0); const char* cB = (const char*)g.Bt + (size_t)cur.pn * tstepB + (cur.br ? g.b_br : 0);
    PG8_STAGE(PG8_SB(0, 0), cB, voffB); PG8_STAGE(PG8_SB(0, 1), cB + hstepB, voffB); PG8_STAGE(PG8_SA(0, 0), cA, voffA); PG8_STAGE(PG8_SA(0, 1), cA + hstepA, voffA);
    if (wr == 1) PG8_BAR;
    PG8_WAIT_V(2); PG8_BAR;
    PG8_STAGE(PG8_SB(1, 0), cB + kstep, voffB); PG8_STAGE(PG8_SA(1, 0), cA + kstep, voffA); PG8_STAGE(PG8_SB(1, 1), cB + hstepB + kstep, voffB);
    PG8_WAIT_V(6); PG8_BAR;
    for (;;) {
        const bool has_next = S.next(ui + 1, nxt);
        const char* nA = has_next ? (const char*)g.A + (size_t)nxt.pm * tstepA + (nxt.br ? g.a_br : 0) : cA; const char* nB = has_next ? (const char*)g.Bt + (size_t)nxt.pn * tstepB + (nxt.br ? g.b_br : 0) : cB;
        for (int t = 0; t < nt; t += 2) {
            const bool last = (t == nt - 2);
            const char* a1 = cA + (size_t)(t + 1) * kstep;
            const char* a2 = last ? nA : cA + (size_t)(t + 2) * kstep; const char* b2 = last ? nB : cB + (size_t)(t + 2) * kstep;
            const char* a3 = a2 + kstep; const char* b3 = b2 + kstep;
            PG8_LDB(B0, 0, 0); PG8_LDB(B1, 0, 1); PG8_SCHED; PG8_LDA(At, 0, 0); PG8_STAGE(PG8_SA(1, 1), a1 + hstepA, voffA);
            PG8_WAIT_V(8); PG8_WAIT_L(0); PG8_BAR; PG8_MMA(0, 0, At, B0); PG8_MMA(0, 1, At, B1); PG8_BAR; PG8_SCHED;
            PG8_LDA(At, 0, 1); PG8_STAGE(PG8_SB(0, 0), b2, voffB); PG8_STAGE(PG8_SB(0, 1), b2 + hstepB, voffB); PG8_STAGE(PG8_SA(0, 0), a2, voffA);
            PG8_WAIT_V(8); PG8_WAIT_L(0); PG8_BAR; PG8_MMA(1, 0, At, B0); PG8_MMA(1, 1, At, B1); PG8_BAR; PG8_SCHED;
            PG8_LDB(B0, 1, 0); PG8_LDB(B1, 1, 1); PG8_SCHED; PG8_LDA(At, 1, 0); PG8_STAGE(PG8_SA(0, 1), a2 + hstepA, voffA);
            PG8_WAIT_V(8); PG8_WAIT_L(0); PG8_BAR; PG8_MMA(0, 0, At, B0); PG8_MMA(0, 1, At, B1); PG8_BAR; PG8_SCHED;
            PG8_LDA(At, 1, 1); PG8_STAGE(PG8_SB(1, 0), b3, voffB); PG8_STAGE(PG8_SB(1, 1), b3 + hstepB, voffB); PG8_STAGE(PG8_SA(1, 0), a3, voffA);
            PG8_WAIT_V(8); PG8_WAIT_L(0); PG8_BAR; PG8_MMA(1, 0, At, B0); PG8_MMA(1, 1, At, B1); PG8_BAR; PG8_SCHED;
        }
        if constexpr (ALIGN_EPI) { if (wr == 0) PG8_BAR; }
        E(acc, cur, wr, wc, fr, fq);
        if (!has_next) break;
        if (!E.keep(cur)) {
#pragma unroll
            for (int a = 0; a < 2; ++a)
#pragma unroll
                for (int b = 0; b < 2; ++b)
#pragma unroll
                    for (int m = 0; m < 4; ++m)
#pragma unroll
                        for (int n = 0; n < 2; ++n) acc[a][b][m][n] = (f32x4){0.f, 0.f, 0.f, 0.f};
        }
        cur = nxt; cA = nA; cB = nB; ++ui;
        if constexpr (ALIGN_EPI) { if (wr == 1) PG8_BAR; }
    }
    PG8_WAIT_V(0);
    if constexpr (!ALIGN_EPI) { if (wr == 0) PG8_BAR; }
    PG8_BAR;
#undef PG8_SA
#undef PG8_SB
#undef PG8_STAGE
#undef PG8_LDA
#undef PG8_LDB
#undef PG8_MMA
#undef PG8_WAIT_V
#undef PG8_WAIT_L
#undef PG8_BAR
#undef PG8_SCHED
}

typedef f32x4 Acc[2][2][4][2];

struct EpiP1 {
    bf16_t* PROJ; bf16_t* GATES; const float* b_gate; const float* qn; const float* kn; const float* tab;
    __device__ __forceinline__ bool keep(const Unit&) const { return false; }
    __device__ __forceinline__ void operator()(Acc& acc, const Unit& u, int wr, int wc, int fr, int fq) const {
        const int row0 = u.pm * BM + wr * 64 + fr;
#if DBG_PLAIN
        {
#pragma unroll
            for (int ai = 0; ai < 2; ++ai)
#pragma unroll
                for (int m = 0; m < 4; ++m) { const size_t row = (size_t)(row0 + ai * HALF + m * 16);
                    bf16_t* rowp = (u.pn >= 6) ? GATES + row * NGATE + 256 * (u.pn - 6) + 64 * wc + 4 * fq : PROJ + row * NPROJ + 256 * u.pn + 64 * wc + 4 * fq;
#pragma unroll
                    for (int bj = 0; bj < 2; ++bj)
#pragma unroll
                        for (int n = 0; n < 2; ++n) { const f32x4 v = acc[ai][bj][m][n]; u32x2 w; w.x = pk2(v[0], v[1]); w.y = pk2(v[2], v[3]); *(u32x2*)(rowp + 32 * bj + 16 * n) = w; } }
            return;
        }
#endif
        if (u.pn >= 6) {
            const int gb = 256 * (u.pn - 6) + 64 * wc + 4 * fq;
            f32x4 bv[2][2];
#pragma unroll
            for (int bj = 0; bj < 2; ++bj)
#pragma unroll
                for (int n = 0; n < 2; ++n) bv[bj][n] = *(const f32x4*)(b_gate + gb + 32 * bj + 16 * n);
#pragma unroll
            for (int ai = 0; ai < 2; ++ai)
#pragma unroll
                for (int m = 0; m < 4; ++m) { bf16_t* rowp = GATES + (size_t)(row0 + ai * HALF + m * 16) * NGATE + gb;
#pragma unroll
                    for (int bj = 0; bj < 2; ++bj)
#pragma unroll
                        for (int n = 0; n < 2; ++n) { const f32x4 v = acc[ai][bj][m][n] + bv[bj][n]; f32x4 s;
#pragma unroll
                            for (int j = 0; j < 4; ++j) s[j] = __builtin_amdgcn_rcpf(1.0f + __builtin_amdgcn_exp2f(-LOG2E * v[j]));
                            u32x2 w; w.x = cvt_pk_bf16(s[0], s[1]); w.y = cvt_pk_bf16(s[2], s[3]); *(u32x2*)(rowp + 32 * bj + 16 * n) = w; } }
            return;
        }
        const int Lb = 256 * u.pn + 64 * wc;
        const bool isQA = Lb < 512, isKA = (Lb >= 512 && Lb < 640), isQB = (Lb >= 768 && Lb < 1280);
        if (isQA || isKA) {
            const float* gain = isQA ? qn : kn; const float osc = isQA ? C2 : 1.0f;
            f32x4 gv[2][2];
#pragma unroll
            for (int bj = 0; bj < 2; ++bj)
#pragma unroll
                for (int n = 0; n < 2; ++n) gv[bj][n] = *(const f32x4*)(gain + 32 * bj + 16 * n + 4 * fq);
#pragma unroll
            for (int ai = 0; ai < 2; ++ai)
#pragma unroll
                for (int m = 0; m < 4; ++m) { const int row = row0 + ai * HALF + m * 16; float ss = 0.f;
#pragma unroll
                    for (int bj = 0; bj < 2; ++bj)
#pragma unroll
                        for (int n = 0; n < 2; ++n) { const f32x4 x = acc[ai][bj][m][n]; ss += (x[0] * x[0] + x[1] * x[1]) + (x[2] * x[2] + x[3] * x[3]); }
                    ss += __shfl_xor(ss, 16); ss += __shfl_xor(ss, 32);
                    const float rinv = osc * __builtin_amdgcn_rsqf(ss * (1.0f / 64.0f) + EPS);
                    const int t = row & seq_mask(row); bf16_t* rowp = PROJ + (size_t)row * NPROJ + Lb + 4 * fq;
#pragma unroll
                    for (int bj = 0; bj < 2; ++bj) { const int pos = bj ? (t & 63) : (t >> 6);
                        const f32x4 c4 = *(const f32x4*)(tab + pos * 16 + 4 * fq), s4 = *(const f32x4*)(tab + 1024 + pos * 16 + 4 * fq);
                        const f32x4 lo = acc[ai][bj][m][0] * gv[bj][0] * rinv, hi = acc[ai][bj][m][1] * gv[bj][1] * rinv;
                        const f32x4 ylo = lo * c4 - hi * s4, yhi = hi * c4 + lo * s4;
                        u32x2 w; w.x = cvt_pk_bf16(ylo[0], ylo[1]); w.y = cvt_pk_bf16(ylo[2], ylo[3]); *(u32x2*)(rowp + 32 * bj) = w;
                        w.x = cvt_pk_bf16(yhi[0], yhi[1]); w.y = cvt_pk_bf16(yhi[2], yhi[3]); *(u32x2*)(rowp + 32 * bj + 16) = w; } }
        } else {
            const float osc = isQB ? C2 : 1.0f;
#pragma unroll
            for (int ai = 0; ai < 2; ++ai)
#pragma unroll
                for (int m = 0; m < 4; ++m) { bf16_t* rowp = PROJ + (size_t)(row0 + ai * HALF + m * 16) * NPROJ + Lb + 4 * fq;
#pragma unroll
                    for (int bj = 0; bj < 2; ++bj)
#pragma unroll
                        for (int n = 0; n < 2; ++n) { const f32x4 v = acc[ai][bj][m][n] * osc; u32x2 w; w.x = cvt_pk_bf16(v[0], v[1]); w.y = cvt_pk_bf16(v[2], v[3]); *(u32x2*)(rowp + 32 * bj + 16 * n) = w; } }
        }
    }
};

struct EpiBranch {
    const bf16_t* GATES; bf16_t* MIX;
    __device__ __forceinline__ bool keep(const Unit& u) const { return u.br == 0; }
    __device__ __forceinline__ void operator()(Acc& acc, const Unit& u, int wr, int wc, int fr, int fq) const {
        const int row0 = u.pm * BM + wr * 64 + fr, cb = u.pn * BM + wc * 32 + 8 * fq;
#pragma unroll
        for (int ai = 0; ai < 2; ++ai)
#pragma unroll
            for (int m = 0; m < 4; ++m) { const size_t row = (size_t)(row0 + ai * HALF + m * 16);
#pragma unroll
                for (int bj = 0; bj < 2; ++bj) {
                    const u32x4 gbw = *(const u32x4*)(GATES + row * NGATE + 1024 + cb + bj * HALF);
                    float gb[8]; gb[0] = bf_lo(gbw.x); gb[1] = bf_hi(gbw.x); gb[2] = bf_lo(gbw.y); gb[3] = bf_hi(gbw.y); gb[4] = bf_lo(gbw.z); gb[5] = bf_hi(gbw.z); gb[6] = bf_lo(gbw.w); gb[7] = bf_hi(gbw.w);
                    if (u.br == 0) {
                        const u32x4 gaw = *(const u32x4*)(GATES + row * NGATE + cb + bj * HALF);
                        float ga[8]; ga[0] = bf_lo(gaw.x); ga[1] = bf_hi(gaw.x); ga[2] = bf_lo(gaw.y); ga[3] = bf_hi(gaw.y); ga[4] = bf_lo(gaw.z); ga[5] = bf_hi(gaw.z); ga[6] = bf_lo(gaw.w); ga[7] = bf_hi(gaw.w);
#pragma unroll
                        for (int n = 0; n < 2; ++n)
#pragma unroll
                            for (int j = 0; j < 4; ++j) acc[ai][bj][m][n][j] *= ga[4 * n + j] * __builtin_amdgcn_rcpf(__builtin_fmaxf(gb[4 * n + j], 1e-30f));
                    } else {
                        f32x4 v0, v1;
#pragma unroll
                        for (int j = 0; j < 4; ++j) { v0[j] = acc[ai][bj][m][0][j] * gb[j]; v1[j] = acc[ai][bj][m][1][j] * gb[4 + j]; }
                        u32x4 w; w.x = cvt_pk_bf16(v0[0], v0[1]); w.y = cvt_pk_bf16(v0[2], v0[3]); w.z = cvt_pk_bf16(v1[0], v1[1]); w.w = cvt_pk_bf16(v1[2], v1[3]);
                        *(u32x4*)(MIX + row * DM + cb + bj * HALF) = w;
                    } } }
    }
};
struct EpiNormOut {
    bf16_t* OUT; float* SS;
    __device__ __forceinline__ bool keep(const Unit&) const { return false; }
    __device__ __forceinline__ void operator()(Acc& acc, const Unit& u, int wr, int wc, int fr, int fq) const {
        const int row0 = u.pm * BM + wr * 64 + fr, cb = u.pn * BM + wc * 32 + 8 * fq;
#pragma unroll
        for (int ai = 0; ai < 2; ++ai)
#pragma unroll
            for (int m = 0; m < 4; ++m) { const size_t row = (size_t)(row0 + ai * HALF + m * 16); float ss = 0.f;
#pragma unroll
                for (int bj = 0; bj < 2; ++bj) { const f32x4 v0 = acc[ai][bj][m][0], v1 = acc[ai][bj][m][1];
                    ss += (v0[0] * v0[0] + v0[1] * v0[1]) + (v0[2] * v0[2] + v0[3] * v0[3]) + (v1[0] * v1[0] + v1[1] * v1[1]) + (v1[2] * v1[2] + v1[3] * v1[3]);
                    u32x4 w; w.x = cvt_pk_bf16(v0[0], v0[1]); w.y = cvt_pk_bf16(v0[2], v0[3]); w.z = cvt_pk_bf16(v1[0], v1[1]); w.w = cvt_pk_bf16(v1[2], v1[3]);
                    *(u32x4*)(OUT + row * DM + cb + bj * HALF) = w; }
                ss += __shfl_xor(ss, 16); ss += __shfl_xor(ss, 32);
                if (fq == 0) SS[row * 16 + u.pn * 4 + wc] = ss; }
    }
};
struct EpiSwiGLU {
    bf16_t* ACT;
    __device__ __forceinline__ bool keep(const Unit&) const { return false; }
    __device__ __forceinline__ void operator()(Acc& acc, const Unit& u, int wr, int wc, int fr, int fq) const {
        const int row0 = u.pm * BM + wr * 64 + fr, cb = u.pn * HALF + wc * 32 + 8 * fq;
#pragma unroll
        for (int ai = 0; ai < 2; ++ai)
#pragma unroll
            for (int m = 0; m < 4; ++m) { const size_t row = (size_t)(row0 + ai * HALF + m * 16); f32x4 a[2];
#pragma unroll
                for (int n = 0; n < 2; ++n)
#pragma unroll
                    for (int j = 0; j < 4; ++j) { const float gt = acc[ai][0][m][n][j], up = acc[ai][1][m][n][j];
                        a[n][j] = gt * __builtin_amdgcn_rcpf(1.0f + __builtin_amdgcn_exp2f(-LOG2E * gt)) * up; }
                u32x4 w; w.x = cvt_pk_bf16(a[0][0], a[0][1]); w.y = cvt_pk_bf16(a[0][2], a[0][3]); w.z = cvt_pk_bf16(a[1][0], a[1][1]); w.w = cvt_pk_bf16(a[1][2], a[1][3]);
                *(u32x4*)(ACT + row * DFF + cb) = w; }
    }
};
}

#define XB_TMO      128
#define XB_XCNT(j)  (256  + 64 * (j))
#define XB_XSUB(j)  (1280 + 64 * (j))
#define XB_XGEN(j)  (2304 + 64 * (j))
#define XB_TOP      3328
#define XB_TOPGEN   3392
#define XCD_BAR_WORDS 3456
#define XB_SPIN_CAP (1u << 18)
constexpr int CW_BAR = 4096;

__device__ __forceinline__ unsigned xb_ld(unsigned* p)              { return __hip_atomic_load(p, __ATOMIC_RELAXED, __HIP_MEMORY_SCOPE_AGENT); }
__device__ __forceinline__ unsigned xb_add(unsigned* p, unsigned v) { return __hip_atomic_fetch_add(p, v, __ATOMIC_RELAXED, __HIP_MEMORY_SCOPE_AGENT); }
__device__ __forceinline__ unsigned xb_xcc_id() { return (unsigned)__builtin_amdgcn_s_getreg((3 << 11) | 20) & 0xFu; }
#define XB_SPIN(cond, bar) do { unsigned _sp = 0; while (cond) { __builtin_amdgcn_s_sleep(1); \
    if ((++_sp & 255u) == 0u) { if (xb_ld(&(bar)[XB_TMO])) break; if (_sp > XB_SPIN_CAP) { atomicAdd(&(bar)[XB_TMO], 1u); break; } } } } while (0)

struct XcdBarrier { unsigned* bar; unsigned x; volatile LAS unsigned* st; };

__device__ __forceinline__ XcdBarrier xcd_barrier_post(unsigned* bar, volatile LAS unsigned* st) {
    XcdBarrier b; b.bar = bar; b.x = xb_xcc_id(); b.st = st;
    if (threadIdx.x == 0) (void)xb_add(&bar[XB_XCNT(b.x)], 1u);
    return b;
}
__device__ __forceinline__ void xcd_barrier_complete(unsigned* bar, unsigned x, unsigned& nloc, unsigned& nx) {
    const unsigned G = gridDim.x * gridDim.y * gridDim.z;
    unsigned sum, cnt, mine, sp = 0u;
    for (;;) {
        sum = 0u; cnt = 0u; mine = 0u;
#pragma unroll
        for (unsigned j = 0; j < 16; ++j) { const unsigned c = xb_ld(&bar[XB_XCNT(j)]); sum += c; cnt += (c > 0u) ? 1u : 0u; mine = (j == x) ? c : mine; }
        if (sum == G) break;
        __builtin_amdgcn_s_sleep(1);
        if ((++sp & 255u) == 0u) { if (xb_ld(&bar[XB_TMO])) break; if (sp > XB_SPIN_CAP) { atomicAdd(&bar[XB_TMO], 1u); break; } }
    }
    nloc = mine > 0u ? mine : 1u; nx = cnt > 0u ? cnt : 1u;
}
__device__ __forceinline__ void xcd_barrier(const XcdBarrier& b) {
    asm volatile("s_waitcnt vmcnt(0)" ::: "memory");
    __syncthreads();
    if (threadIdx.x == 0) {
        unsigned* bar = b.bar;
        __builtin_amdgcn_s_waitcnt(0);
        unsigned nloc = b.st[0], nx = b.st[1];
        if (nloc == 0u) { xcd_barrier_complete(bar, b.x, nloc, nx); b.st[0] = nloc; b.st[1] = nx; }
        const unsigned old = xb_add(&bar[XB_XSUB(b.x)], 1u);
        const unsigned gen = old / nloc;
        if (old + 1u == (gen + 1u) * nloc) {
            __builtin_amdgcn_fence(__ATOMIC_RELEASE, "agent");
            asm volatile("s_waitcnt vmcnt(0)" ::: "memory");
            const unsigned og = xb_add(&bar[XB_TOP], 1u);
            const unsigned tg = og / nx;
            if (og + 1u == (tg + 1u) * nx) xb_add(&bar[XB_TOPGEN], 1u);
            else XB_SPIN(xb_ld(&bar[XB_TOPGEN]) == tg, bar);
            __builtin_amdgcn_fence(__ATOMIC_ACQUIRE, "agent");
            xb_add(&bar[XB_XGEN(b.x)], 1u);
            asm volatile("s_waitcnt vmcnt(0)" ::: "memory");
        } else {
            XB_SPIN(xb_ld(&bar[XB_XGEN(b.x)]) == gen, bar);
            __builtin_amdgcn_fence(__ATOMIC_ACQUIRE, "agent");
            asm volatile("s_waitcnt vmcnt(0)" ::: "memory");
        }
    }
    __syncthreads();
}

struct Args { const float* in[19]; float* out; unsigned char* ws; int ph_lo, ph_hi; };

__device__ __forceinline__ const float* xrow(const Args& a, int m) { return m < MP ? a.in[0] + (size_t)m * DM : a.in[1] + (size_t)(m - MP) * DM; }

__device__ __forceinline__ int rho32(int q) { return 16 * ((q >> 2) & 1) + 4 * (q >> 3) + (q & 3); }
__device__ __forceinline__ int map_p1(int L) { return (L & ~255) + 128 * ((L >> 5) & 1) + 32 * ((L >> 6) & 3) + (L & 31); }
__device__ __forceinline__ int map_perm(int c) { return (c & ~31) + rho32(c & 31); }
__device__ __forceinline__ int map_gu(int c, int g) { return 256 * (c >> 7) + 128 * g + 32 * ((c >> 5) & 3) + rho32(c & 31); }
template <int MAP> __device__ __forceinline__ void p0_transpose_item(const float* W, int K, int N, bf16_t* WT, int lofs, LAS float* scr, int item, int lane) {
    const int nblk = N / 32, kb = item / nblk, nb = item % nblk, k0 = 64 * kb, n0 = 32 * nb;
#pragma unroll 8
    for (int i = 0; i < 32; ++i) { const int kk = 2 * i + (lane >> 5); scr[kk * 33 + (lane & 31)] = W[(size_t)(k0 + kk) * N + n0 + (lane & 31)]; }
    LDS_WAIT(); asm volatile("" ::: "memory");
    const int c = lane & 7;
#pragma unroll
    for (int j = 0; j < 4; ++j) { const int n = (lane >> 3) + 8 * j; const LAS float* s = scr + (8 * c) * 33 + n;
        u32x4 o; o.x = pk2(s[0 * 33], s[1 * 33]); o.y = pk2(s[2 * 33], s[3 * 33]); o.z = pk2(s[4 * 33], s[5 * 33]); o.w = pk2(s[6 * 33], s[7 * 33]);
        const int sc = n0 + n;
        const int dr = MAP == 0 ? map_p1(lofs + sc) : MAP == 1 ? map_perm(sc) : MAP == 2 ? map_gu(sc, 0) : map_gu(sc, 1);
        *(u32x4*)(WT + (size_t)dr * K + k0 + 8 * c) = o; }
    LDS_WAIT(); asm volatile("" ::: "memory");
}
__device__ __forceinline__ int t5_bucket(int rel) {
    const int n = rel < 0 ? -rel : rel;
    const int large = 8 + (n >= 12) + (n >= 16) + (n >= 23) + (n >= 32) + (n >= 46) + (n >= 64) + (n >= 91);
    return (rel > 0 ? 16 : 0) + (n < 8 ? n : large);
}
__device__ __forceinline__ void rms_row_to_bf16(const float* xr_, const float* gain, bf16_t* orow, int lane) {
    const f32x4* xr = (const f32x4*)xr_ + lane; const f32x4* gr = (const f32x4*)gain + lane;
    f32x4 v[4]; float s = 0.f;
#pragma unroll
    for (int j = 0; j < 4; ++j) { v[j] = xr[64 * j]; s += (v[j].x * v[j].x + v[j].y * v[j].y) + (v[j].z * v[j].z + v[j].w * v[j].w); }
    const float rs = __builtin_amdgcn_rsqf(wave_sum(s) * (1.f / DM) + EPS);
    unsigned long long* o8 = (unsigned long long*)orow + lane;
#pragma unroll
    for (int j = 0; j < 4; ++j) { const f32x4 g = gr[64 * j];
        o8[64 * j] = (unsigned long long)pk2(v[j].x * rs * g.x, v[j].y * rs * g.y) | ((unsigned long long)pk2(v[j].z * rs * g.z, v[j].w * rs * g.w) << 32); }
}
__device__ __forceinline__ void p0_prologue(const Args& a, LAS unsigned char* lds, int vcu, int G, int wave, int lane) {
    LAS float* scr = (LAS float*)(lds + wave * 16384);
    unsigned char* ws = a.ws;
    const int gw = vcu * NWAVES + wave, NGW = G * NWAVES;
    constexpr int I_IN = 16 * 48, I_GT = 16 * 64, I_A = 8 * 32, I_B = 8 * 32, I_O = 16 * 32, I_FG = 16 * 88, I_FU = 16 * 88, I_FD = 44 * 32;
    constexpr int NITEMS = I_IN + I_GT + I_A + I_B + I_O + I_FG + I_FU + I_FD;
    for (int it = gw; it < NITEMS; it += NGW) {
        int r = it;
        if (r < I_IN) { p0_transpose_item<0>(a.in[4], 1024, NPROJ, (bf16_t*)(ws + WS_WCAT1), 0, scr, r, lane); continue; } r -= I_IN;
        if (r < I_GT) { p0_transpose_item<0>(a.in[11], 1024, NGATE, (bf16_t*)(ws + WS_WCAT1), NPROJ, scr, r, lane); continue; } r -= I_GT;
        if (r < I_A) { p0_transpose_item<1>(a.in[9], 512, 1024, (bf16_t*)(ws + WS_WA), 0, scr, r, lane); continue; } r -= I_A;
        if (r < I_B) { p0_transpose_item<1>(a.in[10], 512, 1024, (bf16_t*)(ws + WS_WB), 0, scr, r, lane); continue; } r -= I_B;
        if (r < I_O) { p0_transpose_item<1>(a.in[13], 1024, 1024, (bf16_t*)(ws + WS_WOUT), 0, scr, r, lane); continue; } r -= I_O;
        if (r < I_FG) { p0_transpose_item<2>(a.in[16], 1024, DFF, (bf16_t*)(ws + WS_WGU), 0, scr, r, lane); continue; } r -= I_FG;
        if (r < I_FU) { p0_transpose_item<3>(a.in[17], 1024, DFF, (bf16_t*)(ws + WS_WGU), 0, scr, r, lane); continue; } r -= I_FU;
        p0_transpose_item<1>(a.in[18], DFF, 1024, (bf16_t*)(ws + WS_WDN), 0, scr, r, lane);
    }
    float* tab = (float*)(ws + WS_TAB);
    const int gt = gw * 64 + lane;
    if (gt < 1024) { const int pos = gt >> 4, idx = gt & 15; const float inv = 1.0f / powf(10000.0f, (float)idx * (1.0f / 16.0f)); const float ang = (float)pos * inv;
        tab[TAB_COS / 4 + gt] = cosf(ang); tab[TAB_SIN / 4 + gt] = sinf(ang); }
    else if (gt < 1024 + 8 * 768) { const int e = gt - 1024, h = e / 768, i = e % 768; const int rel = i - 384;
        tab[TAB_BTP / 4 + e] = (rel >= -128 && rel <= 128) ? a.in[8][t5_bucket(rel) * 8 + h] * LOG2E : -INFINITY; }
    else if (gt < 1024 + 8 * 768 + 8) { const int h = gt - 1024 - 8 * 768; tab[TAB_SINK / 4 + h] = a.in[7][h] * LOG2E; }
    bf16_t* H = (bf16_t*)(ws + WS_R1);
    for (int m = gw; m < M; m += NGW) rms_row_to_bf16(xrow(a, m), a.in[2], H + (size_t)m * DM, lane);
}

#include <hip/hip_bf16.h>
namespace att {
using bf16=__hip_bfloat16;
using bf16x8=__attribute__((ext_vector_type(8)))short;
using s16x4=__attribute__((ext_vector_type(4)))short;
using f32x16=__attribute__((ext_vector_type(16)))float;
using u32x4=__attribute__((ext_vector_type(4)))unsigned;
constexpr int D=64,QP=1536,OP=1024;
constexpr int NW=8,QBLK=32,QB=QBLK*NW,KVBLK=64;
__device__ __forceinline__ int crow(int r,int hi){return (r&3)+8*(r>>2)+4*hi;}
#define SBAR() __builtin_amdgcn_sched_barrier(0)
__device__ __forceinline__ void cmask(f32x16&p0,f32x16&p1,int jb,int qrel,int hi){
  const float NEG=-INFINITY; int kb=64*jb+4*hi;
  #pragma unroll
  for(int r=0;r<16;++r){int kv=kb+(r&3)+8*(r>>2); if(kv>qrel)p0[r]=NEG; if(kv+32>qrel)p1[r]=NEG;}
}

constexpr int NSLOT=3, SLOTB=8192;
constexpr int LDS_K=0, LDS_V=NSLOT*SLOTB, LDS_WS=2*NSLOT*SLOTB, LDS_OST=LDS_WS+NW*64*4, LDS_BT=LDS_OST+NW*4096, LDS_BYTES=LDS_BT+768*4;
constexpr float C2=0.125f*1.4426950408889634f;
__device__ __forceinline__ void glds16(const void*gsrc,unsigned lds_dst){unsigned keep;
  asm volatile("s_mov_b32 %0, m0\n\ts_mov_b32 m0, %2\n\ts_nop 0\n\tglobal_load_lds_dwordx4 %1, off\n\ts_mov_b32 m0, %0":"=&s"(keep):"v"(gsrc),"s"(lds_dst):"memory");}
__device__ __forceinline__ float max3f(float a,float b,float c){float r;asm("v_max3_f32 %0, %1, %2, %3":"=v"(r):"v"(a),"v"(b),"v"(c));return r;}
__device__ __forceinline__ float max2f(float a,float b){float r;asm("v_max_f32_e32 %0, %1, %2":"=v"(r):"v"(a),"v"(b));return r;}
__device__ __forceinline__ float fadd_s(float a,float b){float r;asm("v_add_f32_e32 %0, %1, %2":"=v"(r):"v"(a),"v"(b));return r;}
__device__ __forceinline__ float fsub_s(float a,float b){float r;asm("v_sub_f32_e32 %0, %1, %2":"=v"(r):"v"(a),"v"(b));return r;}
typedef float f32x2_t __attribute__((ext_vector_type(2))); typedef __bf16 bf16x2_t __attribute__((ext_vector_type(2)));
__device__ __forceinline__ unsigned cvtpk_s(float lo,float hi){f32x2_t v={lo,hi};bf16x2_t b=__builtin_convertvector(v,bf16x2_t);return __builtin_bit_cast(unsigned,b);}
#define WAIT_BAR(N) asm volatile("s_waitcnt vmcnt(" #N ") lgkmcnt(0)\n\ts_barrier":::"memory")

__device__ __forceinline__ void qkt(f32x16&p0,f32x16&p1,const char*Kslot,const bf16x8*qr,const f32x16&negm,int r32,int hi){
  const char*kb=Kslot+hi*1024+r32*16;
  #pragma unroll
  for(int d0=0;d0<4;++d0){
    const bf16x8 b0=*reinterpret_cast<const bf16x8*>(kb+d0*2048);
    const bf16x8 b1=*reinterpret_cast<const bf16x8*>(kb+d0*2048+512);
    if(d0==0){p0=__builtin_amdgcn_mfma_f32_32x32x16_bf16(b0,qr[0],negm,0,0,0);p1=__builtin_amdgcn_mfma_f32_32x32x16_bf16(b1,qr[0],negm,0,0,0);}
    else{p0=__builtin_amdgcn_mfma_f32_32x32x16_bf16(b0,qr[d0],p0,0,0,0);p1=__builtin_amdgcn_mfma_f32_32x32x16_bf16(b1,qr[d0],p1,0,0,0);}}
}
typedef __attribute__((address_space(3))) const char* lds_cptr;
typedef short v4i16_t __attribute__((ext_vector_type(4)));
typedef __attribute__((address_space(3))) const float* lds_fptr;
__device__ __forceinline__ void kload8(bf16x8*kf,lds_cptr kp){
  kf[0]=*(const __attribute__((address_space(3))) bf16x8*)(kp);      kf[1]=*(const __attribute__((address_space(3))) bf16x8*)(kp+512);
  kf[2]=*(const __attribute__((address_space(3))) bf16x8*)(kp+2048); kf[3]=*(const __attribute__((address_space(3))) bf16x8*)(kp+2560);
  kf[4]=*(const __attribute__((address_space(3))) bf16x8*)(kp+4096); kf[5]=*(const __attribute__((address_space(3))) bf16x8*)(kp+4608);
  kf[6]=*(const __attribute__((address_space(3))) bf16x8*)(kp+6144); kf[7]=*(const __attribute__((address_space(3))) bf16x8*)(kp+6656);
}
__device__ __forceinline__ void kload2(bf16x8*kf,lds_cptr kp,int j){ kf[2*j]=*(const __attribute__((address_space(3))) bf16x8*)(kp+j*2048); kf[2*j+1]=*(const __attribute__((address_space(3))) bf16x8*)(kp+j*2048+512); }
__device__ __forceinline__ s16x4 vtr(lds_cptr p){ return __builtin_bit_cast(s16x4,__builtin_amdgcn_ds_read_tr16_b64_v4i16((__attribute__((address_space(3))) v4i16_t*)p)); }
__device__ __forceinline__ float rowmax(const f32x16&p0,const f32x16&p1){
  float a=max3f(p0[0],p0[1],p1[0]),b=max3f(p0[2],p0[3],p1[1]);a=max3f(a,p1[2],p1[3]);
  #pragma unroll
  for(int r=4;r<16;r+=4){a=max3f(a,p0[r],p0[r+1]);b=max3f(b,p0[r+2],p0[r+3]);a=max3f(a,p1[r],p1[r+1]);b=max3f(b,p1[r+2],p1[r+3]);}
  const float m=max2f(a,b);
  auto rr=__builtin_amdgcn_permlane32_swap(__float_as_uint(m),__float_as_uint(m),false,false);
  return max2f(__uint_as_float(rr[0]),__uint_as_float(rr[1]));
}
__device__ __forceinline__ void pv(f32x16*o,int vb,bf16x8 pa0,bf16x8 pa1,bf16x8 pa2,bf16x8 pa3){
  #pragma unroll
  for(int d0=0;d0<2;++d0){s16x4 lo[4],hi[4];
    #pragma unroll
    for(int ks=0;ks<4;++ks){
      asm volatile("ds_read_b64_tr_b16 %0,%1 offset:%c2":"=&v"(lo[ks]):"v"(vb),"i"(d0*4096+ks*1024):"memory");
      asm volatile("ds_read_b64_tr_b16 %0,%1 offset:%c2":"=&v"(hi[ks]):"v"(vb),"i"(d0*4096+ks*1024+512):"memory");}
    asm volatile("s_waitcnt lgkmcnt(0)":::"memory");SBAR();
    #define PK(k) (bf16x8){lo[k][0],lo[k][1],lo[k][2],lo[k][3],hi[k][0],hi[k][1],hi[k][2],hi[k][3]}
    o[d0]=__builtin_amdgcn_mfma_f32_32x32x16_bf16(pa0,PK(0),o[d0],0,0,0);
    o[d0]=__builtin_amdgcn_mfma_f32_32x32x16_bf16(pa1,PK(1),o[d0],0,0,0);
    o[d0]=__builtin_amdgcn_mfma_f32_32x32x16_bf16(pa2,PK(2),o[d0],0,0,0);
    o[d0]=__builtin_amdgcn_mfma_f32_32x32x16_bf16(pa3,PK(3),o[d0],0,0,0);
    #undef PK
  }
}

#ifndef ATTN_STORE16
#define ATTN_STORE16(p,v) (*(u32x4*)(p)=(v))
#endif
template<bool WIN,int THRL> __device__ __forceinline__ void attn_unit(const bf16*Qh,const bf16*__restrict__ Kh,const bf16*__restrict__ Vh,bf16*Oh,const int q0,const int NT,const int kt0,const float sink2,const float*BTg,char*shm){
  int tid_=threadIdx.x; asm volatile("":"+v"(tid_));
  const int tid=tid_,lane=tid&63,r32=lane&31,hi=lane>>5; const int wid=__builtin_amdgcn_readfirstlane(tid>>6);
  const bf16*Qw=Qh+(long)(q0+wid*QBLK)*QP;
  const unsigned lds0=(unsigned)(uintptr_t)shm;
  float*wsf=(float*)(shm+LDS_WS)+wid*64;
  const bf16*ksrc=Kh+(long)(kt0*KVBLK+lane)*QP+wid*8;
  const bf16*vsrc=Vh+(long)(kt0*KVBLK+16*(wid&3)+(lane>>2))*QP+(wid>>2)*32+(lane&3)*8;
  const unsigned kdst=lds0+LDS_K+wid*1024, vdst=lds0+LDS_V+wid*1024;
  #define DMA_K(t,slot) glds16(ksrc+(long)(t)*KVBLK*QP,(unsigned)__builtin_amdgcn_readfirstlane(kdst+(slot)))
  #define DMA_V(t,slot) glds16(vsrc+(long)(t)*KVBLK*QP,(unsigned)__builtin_amdgcn_readfirstlane(vdst+(slot)))
  const int vb0=(int)(lds0+LDS_V)+((lane>>4)&1)*32+(lane&3)*8+(4*hi+((lane&15)>>2))*64;
  const char*Kbase=shm+LDS_K; bf16x8 kf[8];
  const lds_cptr shm3=(lds_cptr)shm; const lds_cptr kp0=shm3+LDS_K+hi*1024+r32*16; const lds_cptr vp0=shm3+LDS_V+((lane>>4)&1)*32+(lane&3)*8+(4*hi+((lane&15)>>2))*64;
  if(WIN){ float*bt=(float*)(shm+LDS_BT); for(int i=tid;i<768;i+=512)bt[i]=BTg[i]; }
  DMA_K(0,0);DMA_V(0,0);DMA_K(1,SLOTB);
  bf16x8 qr[4];
  #pragma unroll
  for(int d0=0;d0<4;++d0)qr[d0]=*reinterpret_cast<const bf16x8*>(&Qw[(long)r32*QP+d0*16+hi*8]);
  float mhat=WIN?sink2:0.f; asm volatile("":"+v"(mhat)); float l_reg=(WIN&&hi==0)?1.f:0.f;f32x16 o[2];o[0]=f32x16{};o[1]=f32x16{};f32x16 negm;
  _Pragma("unroll") for(int r=0;r<16;++r)negm[r]=-mhat;
  asm volatile("":"+v"(negm));
  const lds_fptr btp0=(lds_fptr)(shm3+LDS_BT)+(kt0*KVBLK-q0-wid*QBLK-r32+4*hi+384);
  #define CMASK(P0,P1,t) do{ if(WIN){ const lds_fptr bp_=btp0+(t)*KVBLK; _Pragma("unroll") for(int r4=0;r4<16;r4+=4){ _Pragma("unroll") for(int r=r4;r<r4+4;++r){ P0[r]+=bp_[(r&3)+8*(r>>2)]; P1[r]+=bp_[32+(r&3)+8*(r>>2)]; } SBAR(); } } }while(0)
  bool resc=false;
  #define START(P0,P1) do{ const float rm=rowmax(P0,P1); resc=false; \
    { const float dl=rm; mhat=fadd_s(mhat,dl); \
      _Pragma("unroll") for(int r=0;r<16;++r){P0[r]=fsub_s(P0[r],dl);P1[r]=fsub_s(P1[r],dl);} \
      _Pragma("unroll") for(int r=0;r<16;++r)negm[r]=-mhat; asm volatile("":"+v"(negm)); } \
    _Pragma("unroll") for(int r=0;r<16;++r)P0[r]=__builtin_amdgcn_exp2f(P0[r]); }while(0)
  #define RESC() do{ if(resc){ asm volatile("s_waitcnt lgkmcnt(0)":::"memory"); \
      _Pragma("unroll") for(int d_=0;d_<2;++d_) _Pragma("unroll") for(int r=0;r<16;++r)o[d_][r]*=wsf[crow(r,hi)]; } }while(0)
  #define MX3(a,b,c) __builtin_fmaxf(__builtin_fmaxf((a),(b)),(c))
  f32x16 pA0,pA1,pB0,pB1;
  int sl_prev=0,sl_cur=0,sl_next=SLOTB;
  #define ROT() do{sl_prev=sl_cur;sl_cur=sl_next;sl_next=(sl_next==(NSLOT-1)*SLOTB)?0:sl_next+SLOTB;}while(0)
  DMA_K(2,2*SLOTB);
  WAIT_BAR(3);
  qkt(pA0,pA1,Kbase,qr,negm,r32,hi);asm volatile("s_nop 15\n\ts_nop 7":"+v"(pA0),"+v"(pA1));CMASK(pA0,pA1,0);
  if(WIN){ float a=MX3(pA0[0],pA0[1],pA1[0]),b=MX3(pA0[2],pA0[3],pA1[1]); a=MX3(a,pA1[2],pA1[3]);
    _Pragma("unroll") for(int r=4;r<16;r+=4){a=MX3(a,pA0[r],pA0[r+1]);b=MX3(b,pA0[r+2],pA0[r+3]);a=MX3(a,pA1[r],pA1[r+1]);b=MX3(b,pA1[r+2],pA1[r+3]);}
    float rm=__builtin_fmaxf(a,b); { auto rr=__builtin_amdgcn_permlane32_swap(__float_as_uint(rm),__float_as_uint(rm),false,false); rm=__builtin_fmaxf(__uint_as_float(rr[0]),__uint_as_float(rr[1])); }
    const float dl=__builtin_fmaxf(rm,0.f); mhat+=dl; resc=false;
    _Pragma("unroll") for(int r=0;r<16;++r){pA0[r]-=dl;pA1[r]-=dl;}
    _Pragma("unroll") for(int r=0;r<16;++r)negm[r]=-mhat;
    asm volatile("":"+v"(negm));
    l_reg*=__builtin_amdgcn_exp2f(-dl);
    _Pragma("unroll") for(int r=0;r<16;++r)pA0[r]=__builtin_amdgcn_exp2f(pA0[r]); }
  else { START(pA0,pA1); }
  _Pragma("unroll") for(int r=0;r<16;++r)pA1[r]=__builtin_amdgcn_exp2f(pA1[r]);
  WAIT_BAR(0);
  DMA_K(3,0);DMA_V(1,SLOTB);
  ROT();
  kload8(kf,kp0+sl_cur);
  WAIT_BAR(2);
  s16x4 vlo[8],vhi[8]; u32x4 pw0,pw1,pw2,pw3;
  #define PKW(P,B) cvtpk_s(P[B],P[B+1])
  #define PAF(k) __builtin_bit_cast(bf16x8,pw##k)
  #define VFR(i) (bf16x8){vlo[i][0],vlo[i][1],vlo[i][2],vlo[i][3],vhi[i][0],vhi[i][1],vhi[i][2],vhi[i][3]}
  #define PIN(x) asm volatile("":"+v"(x))
  #define GAPA(MF,A0,A1,A2,A3,W0,W1,PW) do{ MF; sacc+=A0; sacc+=A1; sacc+=A2; sacc+=A3; PIN(sacc); W0; W1; PIN(PW); SBAR(); }while(0)
  #define EX(v) __builtin_amdgcn_exp2f(v)
  #define GAPB(MF,X,B) do{ MF; X[B]=EX(X[B]); X[B+1]=EX(X[B+1]); X[B+2]=EX(X[B+2]); X[B+3]=EX(X[B+3]); PIN(X); SBAR(); }while(0)
  #define VRD(i) do{ vlo[i]=vtr(vp_+(((i)>>2)*4096+((i)&3)*1024)); vhi[i]=vtr(vp_+(((i)>>2)*4096+((i)&3)*1024+512)); }while(0)
  #define KRD(G,j) do{ if(G){ kload2(kf,kp0+sl_next,j); SBAR(); } }while(0)
  #define STEP(C0,C1,P0,P1,t,GK,GV,GL) do{ SBAR(); \
    const lds_cptr vp_=vp0+sl_prev; \
    VRD(0); SBAR(); float sacc=(P0[0]+P0[1]); \
    GAPA(C0=__builtin_amdgcn_mfma_f32_32x32x16_bf16(kf[0],qr[0],negm,0,0,0), P0[2],P0[3],P0[4],P0[5],     pw0[0]=PKW(P0,0), pw0[1]=PKW(P0,2), pw0); \
    VRD(4); SBAR(); GAPA(C1=__builtin_amdgcn_mfma_f32_32x32x16_bf16(kf[1],qr[0],negm,0,0,0), P0[6],P0[7],P0[8],P0[9],     pw0[2]=PKW(P0,4), pw0[3]=PKW(P0,6), pw0); \
    VRD(1); SBAR(); GAPA(C0=__builtin_amdgcn_mfma_f32_32x32x16_bf16(kf[2],qr[1],C0,0,0,0),   P0[10],P0[11],P0[12],P0[13], pw1[0]=PKW(P0,8), pw1[1]=PKW(P0,10), pw1); \
    VRD(5); SBAR(); GAPA(C1=__builtin_amdgcn_mfma_f32_32x32x16_bf16(kf[3],qr[1],C1,0,0,0),   P0[14],P0[15],P1[0],P1[1],   pw1[2]=PKW(P0,12),pw1[3]=PKW(P0,14), pw1); \
    VRD(2); SBAR(); GAPA(C0=__builtin_amdgcn_mfma_f32_32x32x16_bf16(kf[4],qr[2],C0,0,0,0),   P1[2],P1[3],P1[4],P1[5],     pw2[0]=PKW(P1,0), pw2[1]=PKW(P1,2), pw2); \
    VRD(6); SBAR(); GAPA(C1=__builtin_amdgcn_mfma_f32_32x32x16_bf16(kf[5],qr[2],C1,0,0,0),   P1[6],P1[7],P1[8],P1[9],     pw2[2]=PKW(P1,4), pw2[3]=PKW(P1,6), pw2); \
    VRD(3); SBAR(); GAPA(C0=__builtin_amdgcn_mfma_f32_32x32x16_bf16(kf[6],qr[3],C0,0,0,0),   P1[10],P1[11],P1[12],P1[13], pw3[0]=PKW(P1,8), pw3[1]=PKW(P1,10), pw3); \
    VRD(7); SBAR(); GAPA(C1=__builtin_amdgcn_mfma_f32_32x32x16_bf16(kf[7],qr[3],C1,0,0,0),   P1[14],P1[15],0.f,0.f,       pw3[2]=PKW(P1,12),pw3[3]=PKW(P1,14), pw3); \
    l_reg+=sacc; \
    if(GK){DMA_K((t)+3,sl_cur);} if(GV){DMA_V((t)+1,sl_next);} \
    CMASK(C0,C1,t); \
    { float a=MX3(C0[0],C0[1],C1[0]),b=MX3(C0[2],C0[3],C1[1]); a=MX3(a,C1[2],C1[3]); \
      _Pragma("unroll") for(int r=4;r<16;r+=4){a=MX3(a,C0[r],C0[r+1]);b=MX3(b,C0[r+2],C0[r+3]);a=MX3(a,C1[r],C1[r+1]);b=MX3(b,C1[r+2],C1[r+3]);} \
      float rm=__builtin_fmaxf(a,b); { auto rr=__builtin_amdgcn_permlane32_swap(__float_as_uint(rm),__float_as_uint(rm),false,false); rm=__builtin_fmaxf(__uint_as_float(rr[0]),__uint_as_float(rr[1])); } \
      resc=false; \
      if(__builtin_expect(__any(rm>(float)THRL),0)){ const float dl=__builtin_fmaxf(rm,0.f); mhat+=dl; \
        _Pragma("unroll") for(int r=0;r<16;++r){C0[r]-=dl;C1[r]-=dl;} \
        _Pragma("unroll") for(int r=0;r<16;++r)negm[r]=-mhat; asm volatile("":"+v"(negm)); \
        const float f=__builtin_amdgcn_exp2f(-dl); l_reg*=f; if(hi==0)wsf[r32]=f; resc=true; } } \
    SBAR(); \
    GAPB(o[0]=__builtin_amdgcn_mfma_f32_32x32x16_bf16(PAF(0),VFR(0),o[0],0,0,0), C0,0); \
    GAPB(o[1]=__builtin_amdgcn_mfma_f32_32x32x16_bf16(PAF(0),VFR(4),o[1],0,0,0), C0,4); \
    KRD(GL,0); GAPB(o[0]=__builtin_amdgcn_mfma_f32_32x32x16_bf16(PAF(1),VFR(1),o[0],0,0,0), C0,8); \
    KRD(GL,1); GAPB(o[1]=__builtin_amdgcn_mfma_f32_32x32x16_bf16(PAF(1),VFR(5),o[1],0,0,0), C0,12); \
    KRD(GL,2); GAPB(o[0]=__builtin_amdgcn_mfma_f32_32x32x16_bf16(PAF(2),VFR(2),o[0],0,0,0), C1,0); \
    KRD(GL,3); GAPB(o[1]=__builtin_amdgcn_mfma_f32_32x32x16_bf16(PAF(2),VFR(6),o[1],0,0,0), C1,4); \
    GAPB(o[0]=__builtin_amdgcn_mfma_f32_32x32x16_bf16(PAF(3),VFR(3),o[0],0,0,0), C1,8); \
    GAPB(o[1]=__builtin_amdgcn_mfma_f32_32x32x16_bf16(PAF(3),VFR(7),o[1],0,0,0), C1,12); \
    }while(0)
  int t=1;
  for(;t+5<NT;t+=2){
    STEP(pB0,pB1,pA0,pA1,t,true,true,true);     WAIT_BAR(2); RESC(); ROT();
    STEP(pA0,pA1,pB0,pB1,t+1,true,true,true);   WAIT_BAR(2); RESC(); ROT();
  }
  #define ENDW(tt) do{ if((tt)+3<NT){WAIT_BAR(2);} else if((tt)+2<NT){WAIT_BAR(1);} else {WAIT_BAR(0);} }while(0)
  for(;t+1<NT;t+=2){
    STEP(pB0,pB1,pA0,pA1,t,(t+3<NT),(t+1<NT),(t+1<NT));       ENDW(t);   RESC(); ROT();
    STEP(pA0,pA1,pB0,pB1,t+1,(t+4<NT),(t+2<NT),(t+2<NT));     ENDW(t+1); RESC(); ROT();
  }
  STEP(pB0,pB1,pA0,pA1,NT-1,false,false,false); RESC();
  { float sacc=pB0[0]+pB0[1]; _Pragma("unroll") for(int r=2;r<16;++r)sacc+=pB0[r]; _Pragma("unroll") for(int r=0;r<16;++r)sacc+=pB1[r]; l_reg+=sacc;
    pw0=(u32x4){PKW(pB0,0),PKW(pB0,2),PKW(pB0,4),PKW(pB0,6)};pw1=(u32x4){PKW(pB0,8),PKW(pB0,10),PKW(pB0,12),PKW(pB0,14)};pw2=(u32x4){PKW(pB1,0),PKW(pB1,2),PKW(pB1,4),PKW(pB1,6)};pw3=(u32x4){PKW(pB1,8),PKW(pB1,10),PKW(pB1,12),PKW(pB1,14)};
    SBAR(); pv(o,vb0+sl_cur,PAF(0),PAF(1),PAF(2),PAF(3)); }
  #undef PKW
  #undef PAF
  #undef VFR
  #undef PIN
  #undef MX3
  #undef GAPA
  #undef GAPB
  #undef EX
  #undef VRD
  #undef KRD
  #undef STEP
  #undef ENDW
  {auto rr=__builtin_amdgcn_permlane32_swap(__float_as_uint(l_reg),__float_as_uint(l_reg),false,false);l_reg=__uint_as_float(rr[0])+__uint_as_float(rr[1]);}
  if(hi==0)wsf[32+r32]=l_reg;asm volatile("s_waitcnt lgkmcnt(0)":::"memory");
  float rli[16];
  #pragma unroll
  for(int r=0;r<16;++r)rli[r]=__builtin_amdgcn_rcpf(wsf[32+crow(r,hi)]);
  bf16*Ow=Oh+(long)(q0+wid*QBLK)*OP;
  { bf16*stg=(bf16*)(shm+LDS_OST)+wid*2048;
    #pragma unroll
    for(int r=0;r<16;++r){const int orow=crow(r,hi);
      #pragma unroll
      for(int d0=0;d0<2;++d0)stg[orow*64+d0*32+r32]=__float2bfloat16(o[d0][r]*rli[r]);}
    asm volatile("s_waitcnt lgkmcnt(0)":::"memory");
    #pragma unroll
    for(int i=0;i<4;++i){const int row=i*8+(lane>>3),ch=lane&7; const u32x4 v=*(const u32x4*)(stg+row*64+ch*8); ATTN_STORE16(Ow+(long)row*OP+ch*8,v);} }
  asm volatile("s_waitcnt lgkmcnt(0)\n\ts_barrier":::"memory");
  #undef DMA_K
  #undef DMA_V
  #undef CMASK
  #undef START
  #undef RESC
  #undef ROT
}
constexpr int ATTN_LDS_BYTES=LDS_BYTES;
#undef SBAR
#undef WAIT_BAR
}

__device__ __forceinline__ void attn_cu_work(const Args& a, char* lds, int v) {
    using att::bf16;
    const bf16* PROJ = (const bf16*)(a.ws + WS_PROJ); bf16* Y = (bf16*)(a.ws + WS_R1); const float* tab = (const float*)(a.ws + WS_TAB);
    const int xcd = v >> 5, j = v & 31;
    for (int k = 0; k < (ATT_DO_GLOBAL ? 2 : 0); ++k) {
        const int u = 2 * j + k, seq = xcd >> 1, kvh = xcd & 1, h = kvh * 4 + (u & 3), qb = u >> 2; const long row0 = MP + (long)seq * 4096;
        att::attn_unit<false, 8>(PROJ + row0 * NPROJ + h * 64, PROJ + row0 * NPROJ + 512 + kvh * 64, PROJ + row0 * NPROJ + 640 + kvh * 64, Y + row0 * DM + h * 64, qb * 256, 64, 0, 0.f, nullptr, lds); }
    for (int i = 0; i < (ATT_DO_GLOBAL ? 4 : 0); ++i) {
        const int gp = xcd * 4 + i, seq = gp >> 1, kvh = gp & 1, h = kvh * 4 + (j & 3), qb = j >> 2; const long row0 = (long)seq * 2048;
        att::attn_unit<false, 8>(PROJ + row0 * NPROJ + h * 64, PROJ + row0 * NPROJ + 512 + kvh * 64, PROJ + row0 * NPROJ + 640 + kvh * 64, Y + row0 * DM + h * 64, qb * 256, 32, 0, 0.f, nullptr, lds); }
    for (int k = 0; k < (ATT_DO_WIN ? 6 : 0); ++k) {
        const int w = v * 6 + k, rbk = w >> 3, h = w & 7, kvh = h >> 2, m0 = rbk * 256;
        const int smask = seq_mask(m0), S = smask + 1; const long row0 = m0 & ~smask; const int q0 = m0 - (int)row0;
        const int kt0 = q0 >= 128 ? (q0 - 128) / 64 : 0, kend = (q0 + 384 <= S) ? (q0 + 384) / 64 : S / 64;
        att::attn_unit<true, 8>(PROJ + row0 * NPROJ + 768 + h * 64, PROJ + row0 * NPROJ + 1280 + kvh * 64, PROJ + row0 * NPROJ + 1408 + kvh * 64, Y + row0 * DM + 512 + h * 64, q0, kend - kt0, kt0,
                                tab[TAB_SINK / 4 + h], tab + TAB_BTP / 4 + h * 768, lds); }
}
__device__ __forceinline__ void p2_attention(const Args& a, char* lds, int vcu, int G) { for (int v = vcu; v < 256; v += G) attn_cu_work(a, lds, v); }

__device__ __forceinline__ void p3c_rows(const Args& a, int vcu, int G, int wave, int lane) {
    const bf16_t* U = (const bf16_t*)(a.ws + WS_R1); const float* SS = (const float*)(a.ws + WS_SS1); bf16_t* H2 = (bf16_t*)(a.ws + WS_H2);
    const f32x4* gp = (const f32x4*)a.in[3] + lane; const f32x4* gf = (const f32x4*)a.in[14] + lane;
    const int gw = vcu * NWAVES + wave, NGW = G * NWAVES;
    for (int m = gw; m < M; m += NGW) {
        const f32x4* ssp = (const f32x4*)(SS + (size_t)m * 16); const f32x4 s0 = ssp[0], s1 = ssp[1], s2 = ssp[2], s3 = ssp[3];
        const float ss = ((s0.x + s0.y) + (s0.z + s0.w)) + ((s1.x + s1.y) + (s1.z + s1.w)) + ((s2.x + s2.y) + (s2.z + s2.w)) + ((s3.x + s3.y) + (s3.z + s3.w));
        const float rs = __builtin_amdgcn_rsqf(ss * (1.f / DM) + EPS);
        const f32x4* xr = (const f32x4*)xrow(a, m) + lane; const u32x2* ur = (const u32x2*)(U + (size_t)m * DM) + lane;
        f32x4* orow = (f32x4*)(a.out + (size_t)m * DM) + lane;
        f32x4 v[4]; float sq = 0.f;
#pragma unroll
        for (int j = 0; j < 4; ++j) { const f32x4 x = xr[64 * j]; const u32x2 uw = ur[64 * j]; const f32x4 g = gp[64 * j];
            v[j].x = x.x + g.x * bf_lo(uw.x) * rs; v[j].y = x.y + g.y * bf_hi(uw.x) * rs; v[j].z = x.z + g.z * bf_lo(uw.y) * rs; v[j].w = x.w + g.w * bf_hi(uw.y) * rs;
            orow[64 * j] = v[j]; sq += (v[j].x * v[j].x + v[j].y * v[j].y) + (v[j].z * v[j].z + v[j].w * v[j].w); }
        const float rs2 = __builtin_amdgcn_rsqf(wave_sum(sq) * (1.f / DM) + EPS);
        unsigned long long* o8 = (unsigned long long*)(H2 + (size_t)m * DM) + lane;
#pragma unroll
        for (int j = 0; j < 4; ++j) { const f32x4 g = gf[64 * j];
            o8[64 * j] = (unsigned long long)pk2(v[j].x * rs2 * g.x, v[j].y * rs2 * g.y) | ((unsigned long long)pk2(v[j].z * rs2 * g.z, v[j].w * rs2 * g.w) << 32); }
    }
}
__device__ __forceinline__ void p6_rows(const Args& a, int vcu, int G, int wave, int lane) {
    const bf16_t* Fb = (const bf16_t*)(a.ws + WS_F); const float* SS = (const float*)(a.ws + WS_SS2);
    const f32x4* gp = (const f32x4*)a.in[15] + lane;
    const int gw = vcu * NWAVES + wave, NGW = G * NWAVES;
    for (int m = gw; m < M; m += NGW) {
        const f32x4* ssp = (const f32x4*)(SS + (size_t)m * 16); const f32x4 s0 = ssp[0], s1 = ssp[1], s2 = ssp[2], s3 = ssp[3];
        const float ss = ((s0.x + s0.y) + (s0.z + s0.w)) + ((s1.x + s1.y) + (s1.z + s1.w)) + ((s2.x + s2.y) + (s2.z + s2.w)) + ((s3.x + s3.y) + (s3.z + s3.w));
        const float rs = __builtin_amdgcn_rsqf(ss * (1.f / DM) + EPS);
        const u32x2* fr = (const u32x2*)(Fb + (size_t)m * DM) + lane; f32x4* orow = (f32x4*)(a.out + (size_t)m * DM) + lane;
#pragma unroll
        for (int j = 0; j < 4; ++j) { f32x4 x = orow[64 * j]; const u32x2 fw = fr[64 * j]; const f32x4 g = gp[64 * j];
            x.x += g.x * bf_lo(fw.x) * rs; x.y += g.y * bf_hi(fw.x) * rs; x.z += g.z * bf_lo(fw.y) * rs; x.w += g.w * bf_hi(fw.y) * rs; orow[64 * j] = x; }
    }
}

constexpr int N_PHASES = 9;
#ifndef DBG_STOP
#define DBG_STOP -1
#endif
__device__ __forceinline__ void dbg_dump(const Args& a, int k, int vcu, int G, int wave, int lane) {
    const int gw = vcu * NWAVES + wave, NGW = G * NWAVES;
    const unsigned char* ws = a.ws;
    for (int m = gw; m < M; m += NGW) {
        for (int j = 0; j < 16; ++j) { const int c = lane + 64 * j; float v = 0.f;
            auto B = [&](size_t off, size_t ld, int col) { return bf_lo((unsigned)((const bf16_t*)(ws + off))[(size_t)m * ld + col]); };
            if (k == 1) v = B(WS_PROJ, NPROJ, c) + B(WS_PROJ, NPROJ, 512 + c) + B(WS_GATES, NGATE, c) + B(WS_GATES, NGATE, 1024 + c);
            else if (k == 2) v = B(WS_R1, DM, c);
            else if (k == 3) v = B(WS_PROJ, DM, c);
            else if (k == 4) v = B(WS_R1, DM, c) + ((const float*)(ws + WS_SS1))[(size_t)m * 16 + (c & 15)];
            else if (k == 5) v = B(WS_H2, DM, c) + a.out[(size_t)m * DM + c];
            else if (k == 6) v = B(WS_ACT, DFF, c) + B(WS_ACT, DFF, 1024 + c) + B(WS_ACT, DFF, 2048 + (c % 768));
            else if (k == 7) v = B(WS_F, DM, c) + ((const float*)(ws + WS_SS2))[(size_t)m * 16 + (c & 15)];
            else if (k == 0) v = B(WS_R1, DM, c) + B(WS_WCAT1, DM, c) + B(WS_WGU, DM, c) + B(WS_WDN, DFF, c) + B(WS_WA, 512, c & 511) + B(WS_WOUT, DM, c) + ((const float*)(ws + WS_TAB))[(c + m) % 3100];
            a.out[(size_t)m * DM + c] = v; }
    }
}
__global__ void __launch_bounds__(NWAVES * 64, 2) enc_fwd(Args args) {
    extern __shared__ __attribute__((aligned(16))) unsigned char lds_raw[];
    LAS unsigned char* lds = (LAS unsigned char*)lds_raw;
    volatile LAS unsigned* MISC = (volatile LAS unsigned*)(lds + MISC_OFF);
    const int tid = threadIdx.x, lane = tid & 63, wave = __builtin_amdgcn_readfirstlane(tid >> 6);
    const int G = gridDim.x; const int bx = blockIdx.x; const int vcu = (G % 8 == 0) ? (bx % 8) * (G / 8) + bx / 8 : bx;
    unsigned char* ws = args.ws;
    gu32* ctl = (gu32*)(ws + WS_CTL);
    for (int u = tid; u < (LDS_BYTES - LDSCTL_OFF) / 4; u += NWAVES * 64) ((LAS unsigned*)(lds + LDSCTL_OFF))[u] = 0u;
    __syncthreads();
    XcdBarrier bar; bar.bar = (unsigned*)(ctl + CW_BAR); bar.x = 0; bar.st = nullptr;
    const int lo = args.ph_lo, hi = args.ph_hi;
    const bool multi = (hi - lo) > 1;
    if (multi) bar = xcd_barrier_post((unsigned*)(ctl + CW_BAR), MISC + 8);
#define IN(k) (lo <= (k) && (k) < hi)
#define SEAM(k) do { if (IN(k) && IN((k) + 1)) xcd_barrier(bar); } while (0)

    if (IN(0)) { p0_prologue(args, lds, vcu, G, wave, lane); SEAM(0); }

    if (IN(1)) {
        pg8::Gemm g{(const bf16_t*)(ws + WS_R1), (const bf16_t*)(ws + WS_WCAT1), DM, DM, DM, 0, 0};
        pg8::StaticOrder S; S.init(M, NCAT1, G, bx, 0);
        pg8::EpiP1 E{(bf16_t*)(ws + WS_PROJ), (bf16_t*)(ws + WS_GATES), args.in[12], args.in[5], args.in[6], (const float*)(ws + WS_TAB)};
        pg8::gemm_phase<pg8::EpiP1, pg8::StaticOrder, true>(lds, g, S, E);
        SEAM(1);
    }
    if (IN(2)) { p2_attention(args, (char*)lds_raw, vcu, G); SEAM(2); }

    if (IN(3)) {
        pg8::Gemm g{(const bf16_t*)(ws + WS_R1), (const bf16_t*)(ws + WS_WA), DM, 512, 512, 512 * 2, (size_t)(WS_WB - WS_WA)};
        pg8::StaticOrder S; S.init(M, DM, G, bx, 1);
        pg8::EpiBranch E{(const bf16_t*)(ws + WS_GATES), (bf16_t*)(ws + WS_PROJ)};
        pg8::gemm_phase<pg8::EpiBranch, pg8::StaticOrder, true>(lds, g, S, E);
        SEAM(3);
    }
    if (IN(4)) {
        pg8::Gemm g{(const bf16_t*)(ws + WS_PROJ), (const bf16_t*)(ws + WS_WOUT), DM, DM, DM, 0, 0};
        pg8::StaticOrder S; S.init(M, DM, G, bx, 0);
        pg8::EpiNormOut E{(bf16_t*)(ws + WS_R1), (float*)(ws + WS_SS1)};
        pg8::gemm_phase<pg8::EpiNormOut, pg8::StaticOrder, true>(lds, g, S, E);
        SEAM(4);
    }
    if (IN(5)) { p3c_rows(args, vcu, G, wave, lane); SEAM(5); }

    if (IN(6)) {
        pg8::Gemm g{(const bf16_t*)(ws + WS_H2), (const bf16_t*)(ws + WS_WGU), DM, DM, DM, 0, 0};
        pg8::StaticOrder S; S.init(M, NGU, G, bx, 0);
        pg8::EpiSwiGLU E{(bf16_t*)(ws + WS_ACT)};
        pg8::gemm_phase<pg8::EpiSwiGLU, pg8::StaticOrder, true>(lds, g, S, E);
        SEAM(6);
    }
    if (IN(7)) {
        pg8::Gemm g{(const bf16_t*)(ws + WS_ACT), (const bf16_t*)(ws + WS_WDN), DFF, DFF, DFF, 0, 0};
        pg8::StaticOrder S; S.init(M, DM, G, bx, 0);
        pg8::EpiNormOut E{(bf16_t*)(ws + WS_F), (float*)(ws + WS_SS2)};
        pg8::gemm_phase<pg8::EpiNormOut, pg8::StaticOrder, true>(lds, g, S, E);
        SEAM(7);
    }
    if (IN(8)) { p6_rows(args, vcu, G, wave, lane); }
    if (IN(100)) { dbg_dump(args, DBG_STOP, vcu, G, wave, lane); }
#undef IN
#undef SEAM
}

extern "C" void kernel_launch(void* const* d_in, const int* in_sizes, int n_in, void* d_out, int out_size, void* d_ws, size_t ws_size, hipStream_t stream) {
    static int grid = 0;
    if (grid == 0) {
        if (n_in != 19 || out_size != M * DM || ws_size < WS_END) { fprintf(stderr, "kernel_launch: unexpected shapes: n_in %d out %d ws %zu\n", n_in, out_size, ws_size); grid = -1; return; }
        int dev = 0, cus = 0, per_cu = 0;
        if (hipGetDevice(&dev) != hipSuccess || hipDeviceGetAttribute(&cus, hipDeviceAttributeMultiprocessorCount, dev) != hipSuccess) { grid = -1; return; }
        if (hipFuncSetAttribute((const void*)enc_fwd, hipFuncAttributeMaxDynamicSharedMemorySize, LDS_BYTES) != hipSuccess) { fprintf(stderr, "kernel_launch: hipFuncSetAttribute failed\n"); grid = -1; return; }
        if (hipOccupancyMaxActiveBlocksPerMultiprocessor(&per_cu, (const void*)enc_fwd, NWAVES * 64, LDS_BYTES) != hipSuccess || per_cu < 1)
            fprintf(stderr, "kernel_launch: note: occupancy query reports %d workgroups per CU\n", per_cu);
        (void)hipGetLastError();
        grid = cus;
    }
    if (grid < 0) return;
    if (hipMemsetAsync((char*)d_ws + WS_CTL, 0, CTL_ZERO_BYTES, stream) != hipSuccess) return;
    Args a{};
    for (int i = 0; i < 19; ++i) a.in[i] = (const float*)d_in[i];
    a.out = (float*)d_out; a.ws = (unsigned char*)d_ws;
#if MK_ONE_LAUNCH
    a.ph_lo = 0; a.ph_hi = N_PHASES;
    hipLaunchKernelGGL(enc_fwd, dim3(grid), dim3(NWAVES * 64), LDS_BYTES, stream, a);
#else
    for (int p = 0; p <= (DBG_STOP < 0 ? N_PHASES - 1 : DBG_STOP); ++p) { a.ph_lo = p; a.ph_hi = p + 1; hipLaunchKernelGGL(enc_fwd, dim3(grid), dim3(NWAVES * 64), LDS_BYTES, stream, a); }
    if (DBG_STOP >= 0) { a.ph_lo = 100; a.ph_hi = 101; hipLaunchKernelGGL(enc_fwd, dim3(grid), dim3(NWAVES * 64), LDS_BYTES, stream, a); }
#endif
}
```
